# Optimizing an MI355X kernel written in HIP

```python
import math
import jax
import jax.numpy as jnp
from jax import lax
import numpy as np

D_MODEL = 1024
BATCH = 4
SEQ = 8192
DEPTH = 2

N_META = 16
ROPE_THETA = 500000.0
EPS = 1e-6
Q_BLOCK = 128
CHUNK = 128
NEG = -1e30

MLA_HEADS = 8
MLA_NOPE = 64
MLA_ROPE = 32
MLA_QK = MLA_NOPE + MLA_ROPE
MLA_V = 64
MLA_Q_RANK = 384
MLA_KV_RANK = 256

SSD_HEADS = 8
SSD_HEAD_DIM = 64
SSD_INNER = SSD_HEADS * SSD_HEAD_DIM
SSD_GROUPS = 2
SSD_STATE = 64
SSD_CONV = 5
SSD_CONV_CH = SSD_INNER + 2 * SSD_GROUPS * SSD_STATE

DIFF_HEADS = 4
DIFF_QK = 64
DIFF_V = 2 * DIFF_QK
DIFF_ROPE = DIFF_QK // 4

MLSTM_HEADS = 4
MLSTM_QK = 64
MLSTM_V = 128

D_MIX = MLA_HEADS * MLA_V + SSD_INNER + DIFF_HEADS * DIFF_V + MLSTM_HEADS * MLSTM_V
D_FF = -(-8 * D_MODEL // (3 * 256)) * 256

IN_SPLITS = (
    MLA_Q_RANK, MLA_KV_RANK, MLA_ROPE,
    SSD_INNER, SSD_CONV_CH, 2 * SSD_HEADS,
    2 * DIFF_HEADS * DIFF_QK, 2 * DIFF_HEADS * DIFF_QK, DIFF_HEADS * DIFF_V,
    MLSTM_HEADS * MLSTM_QK, MLSTM_HEADS * MLSTM_QK, MLSTM_HEADS * MLSTM_V,
    MLSTM_HEADS * MLSTM_V, 2 * MLSTM_HEADS, 2 * MLSTM_HEADS,
)
IN_COLS = sum(IN_SPLITS)

kernel_name = 'hybrid_mla_ssd_diff_mlstm_encoder'


def rms_norm(x, g):
    xf = x.astype(jnp.float32)
    y = xf * lax.rsqrt(jnp.mean(xf * xf, axis=-1, keepdims=True) + EPS)
    return (y * g.astype(jnp.float32)).astype(x.dtype)


def split_columns(u, sizes):
    out, start = [], 0
    for s in sizes:
        out.append(u[..., start:start + s])
        start += s
    return out


def rope_tables(n_pos, rot_dim):
    inv = 1.0 / (ROPE_THETA ** (jnp.arange(0, rot_dim, 2, dtype=jnp.float32) / rot_dim))
    ang = jnp.arange(n_pos, dtype=jnp.float32)[:, None] * inv[None, :]
    return jnp.cos(ang), jnp.sin(ang)


def apply_partial_rope(x, cos, sin):
    r = cos.shape[-1]
    c = cos[None, :, None, :].astype(x.dtype)
    s = sin[None, :, None, :].astype(x.dtype)
    x1, x2, rest = x[..., :r], x[..., r:2 * r], x[..., 2 * r:]
    return jnp.concatenate([x1 * c - x2 * s, x2 * c + x1 * s, rest], axis=-1)


def softmax_probs(qb, k, scale):
    s = jnp.einsum('bqhd,bkhd->bhqk', qb, k).astype(jnp.float32) * scale
    return jax.nn.softmax(s, axis=-1)


def sweep_query_blocks(attend, q):
    b, t, h, d = q.shape
    n_blk = (t - N_META) // Q_BLOCK
    out_meta = attend(q[:, :N_META])
    q_blocks = jnp.transpose(q[:, N_META:].reshape(b, n_blk, Q_BLOCK, h, d), (1, 0, 2, 3, 4))
    ob = lax.map(attend, q_blocks)
    out_real = jnp.transpose(ob, (1, 0, 2, 3, 4)).reshape((b, n_blk * Q_BLOCK) + ob.shape[3:])
    return jnp.concatenate([out_meta, out_real], axis=1)


def pad_front(u, n, value=0.0):
    return jnp.pad(u, [(0, 0), (n, 0)] + [(0, 0)] * (u.ndim - 2), constant_values=value)


def mla_mixer(c_q, c_kv, k_rope, q_norm_g, kv_norm_g, w_uq, w_ukv, q_head_g, k_head_g, out_g, cos, sin):
    b, t, _ = c_q.shape
    q = (rms_norm(c_q, q_norm_g) @ w_uq).reshape(b, t, MLA_HEADS, MLA_QK)
    kv = (rms_norm(c_kv, kv_norm_g) @ w_ukv).reshape(b, t, MLA_HEADS, MLA_NOPE + MLA_V)
    k_nope, v = kv[..., :MLA_NOPE], kv[..., MLA_NOPE:]
    k_r = jnp.broadcast_to(k_rope[:, :, None, :], (b, t, MLA_HEADS, MLA_ROPE))
    k = jnp.concatenate([k_r, k_nope], axis=-1)
    q = apply_partial_rope(rms_norm(q, q_head_g), cos, sin)
    k = apply_partial_rope(rms_norm(k, k_head_g), cos, sin)
    scale = MLA_QK ** -0.5

    def attend(qb):
        p = softmax_probs(qb, k, scale)
        return jnp.einsum('bhqk,bkhd->bqhd', p.astype(v.dtype), v)

    o = sweep_query_blocks(attend, q).reshape(b, t, MLA_HEADS * MLA_V)
    return rms_norm(o, out_g)


def depthwise_conv_centred(u, w, bias):
    y = lax.conv_general_dilated(
        u, w[:, None, :].astype(u.dtype), window_strides=(1,),
        padding=[(SSD_CONV // 2, SSD_CONV // 2)],
        dimension_numbers=('NWC', 'WIO', 'NWC'), feature_group_count=u.shape[-1])
    return y + bias.astype(u.dtype)


def segsum(a):
    l = a.shape[-1]
    xr = jnp.broadcast_to(a[..., :, None], a.shape + (l,))
    xr = jnp.where(jnp.tril(jnp.ones((l, l), dtype=bool), -1), xr, 0.0)
    out = jnp.cumsum(xr, axis=-2)
    return jnp.where(jnp.tril(jnp.ones((l, l), dtype=bool)), out, -jnp.inf)


def ssd_chunked(x, a, bm, cm):
    b, t, h, p = x.shape
    c = t // CHUNK
    x = x.reshape(b, c, CHUNK, h, p)
    bm = bm.reshape(b, c, CHUNK, h, -1)
    cm = cm.reshape(b, c, CHUNK, h, -1)
    a = jnp.transpose(a.reshape(b, c, CHUNK, h), (0, 3, 1, 2))
    a_cs = jnp.cumsum(a, axis=-1)
    scores = jnp.einsum('bclhn,bcshn->bhcls', cm, bm) * jnp.exp(segsum(a))
    y_diag = jnp.einsum('bhcls,bcshp->bclhp', scores, x)
    decay_states = jnp.transpose(jnp.exp(a_cs[..., -1:] - a_cs), (0, 2, 3, 1))[..., None]
    states = jnp.einsum('bclhn,bclhp->bchpn', bm * decay_states, x)
    states = jnp.concatenate([jnp.zeros_like(states[:, :1]), states], axis=1)
    decay_chunk = jnp.exp(segsum(jnp.pad(a_cs[..., -1], [(0, 0), (0, 0), (1, 0)])))
    states = jnp.einsum('bhzc,bchpn->bzhpn', decay_chunk, states)[:, :-1]
    state_decay = jnp.transpose(jnp.exp(a_cs), (0, 2, 3, 1))[..., None]
    y_off = jnp.einsum('bclhn,bchpn->bclhp', cm, states) * state_decay
    return (y_diag + y_off).reshape(b, t, h, p)


def ssd_direction(xs, dt, a, bm, cm, reverse):
    n_pad = CHUNK - N_META

    def prep(u):
        u = pad_front(u, n_pad)
        return u[:, ::-1] if reverse else u

    heads_per_group = SSD_HEADS // SSD_GROUPS
    y = ssd_chunked(prep(xs * dt[..., None]), prep(dt * a),
                    prep(jnp.repeat(bm, heads_per_group, axis=2)),
                    prep(jnp.repeat(cm, heads_per_group, axis=2)))
    y = y[:, ::-1] if reverse else y
    return y[:, n_pad:]


def ssd_mixer(z, xbc, dt_raw, conv_w, conv_b, dt_bias, a_log, d_skip, norm_g):
    b, t, _ = xbc.shape
    xbc = jax.nn.silu(depthwise_conv_centred(xbc, conv_w, conv_b))
    xs, bm, cm = split_columns(xbc, (SSD_INNER, SSD_GROUPS * SSD_STATE, SSD_GROUPS * SSD_STATE))
    xs = xs.reshape(b, t, SSD_HEADS, SSD_HEAD_DIM)
    bm = bm.reshape(b, t, SSD_GROUPS, SSD_STATE)
    cm = cm.reshape(b, t, SSD_GROUPS, SSD_STATE)
    dt = jax.nn.softplus(dt_raw.reshape(b, t, 2, SSD_HEADS).astype(jnp.float32) + dt_bias.astype(jnp.float32))
    a = -jnp.exp(a_log.astype(jnp.float32))
    y = (ssd_direction(xs, dt[:, :, 0], a[0], bm, cm, False)
         + ssd_direction(xs, dt[:, :, 1], a[1], bm, cm, True)
         + d_skip[None, None, :, None] * xs)
    y = y.reshape(b, t, SSD_INNER)
    return rms_norm(y * jax.nn.silu(z), norm_g)


def diff_mixer(q, k, v, q_head_g, k_head_g, lam, out_g, lambda_init, cos, sin):
    b, t, _ = q.shape
    q = apply_partial_rope(rms_norm(q.reshape(b, t, 2 * DIFF_HEADS, DIFF_QK), q_head_g), cos, sin)
    k = apply_partial_rope(rms_norm(k.reshape(b, t, 2 * DIFF_HEADS, DIFF_QK), k_head_g), cos, sin)
    v = v.reshape(b, t, DIFF_HEADS, DIFF_V)
    lam = lam.astype(jnp.float32)
    lam_full = jnp.exp(jnp.sum(lam[0] * lam[1])) - jnp.exp(jnp.sum(lam[2] * lam[3])) + lambda_init
    scale = DIFF_QK ** -0.5

    def attend(qb):
        p = softmax_probs(qb, k, scale).reshape(b, DIFF_HEADS, 2, qb.shape[1], t)
        amap = p[:, :, 0] - lam_full * p[:, :, 1]
        return jnp.einsum('bhqk,bkhd->bqhd', amap.astype(v.dtype), v)

    o = sweep_query_blocks(attend, q)
    o = rms_norm(o, out_g) * (1.0 - lambda_init)
    return o.reshape(b, t, DIFF_HEADS * DIFF_V)


def mlstm_chunk(carry, inputs):
    c_st, n_st, m_st = carry
    qc, kc, vc, ic, fc = inputs
    ic = jnp.swapaxes(ic, 1, 2)
    fc = jnp.swapaxes(fc, 1, 2)
    bcum = jnp.cumsum(fc, axis=-1)
    causal = jnp.tril(jnp.ones((CHUNK, CHUNK), dtype=bool))
    dmat = jnp.where(causal, bcum[..., :, None] - bcum[..., None, :] + ic[..., None, :], -jnp.inf)
    inter = bcum + m_st[..., None]
    m_row = jnp.maximum(jnp.max(dmat, axis=-1), inter)
    w_intra = jnp.exp(dmat - m_row[..., None])
    w_inter = jnp.exp(inter - m_row)
    s = jnp.einsum('blhd,bshd->bhls', qc, kc).astype(jnp.float32) * w_intra
    num = (jnp.einsum('bhls,bshv->blhv', s, vc)
           + jnp.swapaxes(w_inter, 1, 2)[..., None] * jnp.einsum('bhvd,blhd->blhv', c_st, qc))
    den = jnp.sum(s, axis=-1) + w_inter * jnp.einsum('bhd,blhd->bhl', n_st, qc)
    den = jnp.maximum(jnp.abs(den), jnp.exp(-m_row))
    h = num / jnp.swapaxes(den, 1, 2)[..., None]
    g_last = bcum[..., -1]
    d_last = g_last[..., None] - bcum + ic
    m_new = jnp.maximum(g_last + m_st, jnp.max(d_last, axis=-1))
    w_s = jnp.swapaxes(jnp.exp(d_last - m_new[..., None]), 1, 2)[..., None]
    w_prev = jnp.exp(g_last + m_st - m_new)
    c_new = w_prev[..., None, None] * c_st + jnp.einsum('bshv,bshd->bhvd', vc * w_s, kc)
    n_new = w_prev[..., None] * n_st + jnp.sum(kc * w_s, axis=1)
    return (c_new.astype(jnp.float32), n_new.astype(jnp.float32), m_new.astype(jnp.float32)), h.astype(jnp.float32)


def mlstm_direction(q, k, v, i_log, f_log, reverse):
    n_pad = CHUNK - N_META

    def prep(u, value=0.0):
        u = pad_front(u, n_pad, value)
        return u[:, ::-1] if reverse else u

    qp, kp, vp = prep(q), prep(k), prep(v)
    ip, fp = prep(i_log, NEG), prep(f_log)
    b, t = qp.shape[:2]
    c = t // CHUNK

    def to_chunks(u):
        return jnp.moveaxis(u.reshape((b, c, CHUNK) + u.shape[2:]), 1, 0)

    init = (jnp.zeros((b, MLSTM_HEADS, MLSTM_V, MLSTM_QK), jnp.float32),
            jnp.zeros((b, MLSTM_HEADS, MLSTM_QK), jnp.float32),
            jnp.full((b, MLSTM_HEADS), NEG, jnp.float32))
    _, h = lax.scan(mlstm_chunk, init, (to_chunks(qp), to_chunks(kp), to_chunks(vp), to_chunks(ip), to_chunks(fp)))
    h = jnp.moveaxis(h, 0, 1).reshape(b, t, MLSTM_HEADS, MLSTM_V)
    h = h[:, ::-1] if reverse else h
    return h[:, n_pad:]


def mlstm_mixer(q, k, v, o_raw, i_raw, f_raw, i_bias, f_bias, out_g):
    b, t, _ = q.shape
    q = q.reshape(b, t, MLSTM_HEADS, MLSTM_QK) * (MLSTM_QK ** -0.5)
    k = k.reshape(b, t, MLSTM_HEADS, MLSTM_QK)
    v = v.reshape(b, t, MLSTM_HEADS, MLSTM_V)
    i_log = i_raw.reshape(b, t, 2, MLSTM_HEADS).astype(jnp.float32) + i_bias.astype(jnp.float32)
    f_log = jax.nn.log_sigmoid(f_raw.reshape(b, t, 2, MLSTM_HEADS).astype(jnp.float32) + f_bias.astype(jnp.float32))
    h = (mlstm_direction(q, k, v, i_log[:, :, 0], f_log[:, :, 0], False)
         + mlstm_direction(q, k, v, i_log[:, :, 1], f_log[:, :, 1], True))
    h = rms_norm(h, out_g).reshape(b, t, MLSTM_HEADS * MLSTM_V)
    return jax.nn.sigmoid(o_raw) * h


def setup_inputs(seed: int = 0) -> dict:
    key = jax.random.key(seed)
    ks = iter(jax.random.split(key, 32))
    L = DEPTH

    def nrm(shape, scale):
        return scale * jax.random.normal(next(ks), shape, jnp.float32)

    def gain(shape):
        return 1.0 + 0.02 * jax.random.normal(next(ks), shape, jnp.float32)

    x = nrm((BATCH, SEQ, D_MODEL), 1.0)
    meta_tokens = nrm((N_META, D_MODEL), 1.0)
    attn_norm_g = gain((L, D_MODEL))
    w_in = nrm((L, D_MODEL, IN_COLS), D_MODEL ** -0.5)
    mla_q_norm_g = gain((L, MLA_Q_RANK))
    mla_kv_norm_g = gain((L, MLA_KV_RANK))
    mla_w_uq = nrm((L, MLA_Q_RANK, MLA_HEADS * MLA_QK), MLA_Q_RANK ** -0.5)
    mla_w_ukv = nrm((L, MLA_KV_RANK, MLA_HEADS * (MLA_NOPE + MLA_V)), MLA_KV_RANK ** -0.5)
    mla_q_head_g = gain((L, MLA_QK))
    mla_k_head_g = gain((L, MLA_QK))
    mla_out_g = gain((L, MLA_HEADS * MLA_V))
    ssd_conv_w = nrm((L, SSD_CONV, SSD_CONV_CH), SSD_CONV ** -0.5)
    ssd_conv_b = nrm((L, SSD_CONV_CH), 0.02)
    dt0 = jnp.exp(jax.random.uniform(next(ks), (L, 2, SSD_HEADS), jnp.float32, math.log(1e-3), math.log(1e-1)))
    ssd_dt_bias = dt0 + jnp.log(-jnp.expm1(-dt0))
    ssd_a_log = jnp.log(jax.random.uniform(next(ks), (L, 2, SSD_HEADS), jnp.float32, 1.0, 16.0))
    ssd_d = gain((L, SSD_HEADS))
    ssd_norm_g = gain((L, SSD_INNER))
    diff_q_head_g = gain((L, DIFF_QK))
    diff_k_head_g = gain((L, DIFF_QK))
    diff_lambda = nrm((L, 4, DIFF_QK), 0.1)
    diff_out_g = gain((L, DIFF_V))
    mlstm_i_bias = nrm((L, 2, MLSTM_HEADS), 0.1)
    mlstm_f_bias = 3.0 + nrm((L, 2, MLSTM_HEADS), 0.5)
    mlstm_out_g = gain((L, MLSTM_V))
    w_out = nrm((L, D_MIX, D_MODEL), D_MIX ** -0.5)
    ffn_norm_g = gain((L, D_MODEL))
    w_ffn_in = nrm((L, D_MODEL, 2 * D_FF), D_MODEL ** -0.5)
    w_ffn_out = nrm((L, D_FF, D_MODEL), D_FF ** -0.5)
    return {'x': x, 'meta_tokens': meta_tokens, 'attn_norm_g': attn_norm_g, 'w_in': w_in,
            'mla_q_norm_g': mla_q_norm_g, 'mla_kv_norm_g': mla_kv_norm_g, 'mla_w_uq': mla_w_uq,
            'mla_w_ukv': mla_w_ukv, 'mla_q_head_g': mla_q_head_g, 'mla_k_head_g': mla_k_head_g,
            'mla_out_g': mla_out_g, 'ssd_conv_w': ssd_conv_w, 'ssd_conv_b': ssd_conv_b,
            'ssd_dt_bias': ssd_dt_bias, 'ssd_a_log': ssd_a_log, 'ssd_d': ssd_d, 'ssd_norm_g': ssd_norm_g,
            'diff_q_head_g': diff_q_head_g, 'diff_k_head_g': diff_k_head_g, 'diff_lambda': diff_lambda,
            'diff_out_g': diff_out_g, 'mlstm_i_bias': mlstm_i_bias, 'mlstm_f_bias': mlstm_f_bias,
            'mlstm_out_g': mlstm_out_g, 'w_out': w_out, 'ffn_norm_g': ffn_norm_g,
            'w_ffn_in': w_ffn_in, 'w_ffn_out': w_ffn_out}


def reference(x, meta_tokens, attn_norm_g, w_in, mla_q_norm_g, mla_kv_norm_g, mla_w_uq, mla_w_ukv,
              mla_q_head_g, mla_k_head_g, mla_out_g, ssd_conv_w, ssd_conv_b, ssd_dt_bias, ssd_a_log,
              ssd_d, ssd_norm_g, diff_q_head_g, diff_k_head_g, diff_lambda, diff_out_g,
              mlstm_i_bias, mlstm_f_bias, mlstm_out_g, w_out, ffn_norm_g, w_ffn_in, w_ffn_out):
    b = x.shape[0]
    meta = jnp.broadcast_to(meta_tokens[None].astype(x.dtype), (b, N_META, D_MODEL))
    h = jnp.concatenate([meta, x], axis=1)
    t = h.shape[1]
    cos_d, sin_d = rope_tables(t, DIFF_ROPE)
    cos_m, sin_m = rope_tables(t, MLA_ROPE)
    for l in range(DEPTH):
        lambda_init = 0.8 - 0.6 * math.exp(-0.3 * l)
        hn = rms_norm(h, attn_norm_g[l])
        proj = hn @ w_in[l]
        (c_q, c_kv, k_rope, ssd_z, ssd_xbc, ssd_dt, d_q, d_k, d_v,
         m_q, m_k, m_v, m_o, m_i, m_f) = split_columns(proj, IN_SPLITS)
        y_a = mla_mixer(c_q, c_kv, k_rope, mla_q_norm_g[l], mla_kv_norm_g[l], mla_w_uq[l], mla_w_ukv[l],
                        mla_q_head_g[l], mla_k_head_g[l], mla_out_g[l], cos_m, sin_m)
        y_b = ssd_mixer(ssd_z, ssd_xbc, ssd_dt, ssd_conv_w[l], ssd_conv_b[l], ssd_dt_bias[l],
                        ssd_a_log[l], ssd_d[l], ssd_norm_g[l])
        y_c = diff_mixer(d_q, d_k, d_v, diff_q_head_g[l], diff_k_head_g[l], diff_lambda[l],
                         diff_out_g[l], lambda_init, cos_d, sin_d)
        y_d = mlstm_mixer(m_q, m_k, m_v, m_o, m_i, m_f, mlstm_i_bias[l], mlstm_f_bias[l], mlstm_out_g[l])
        mixed = jnp.concatenate([y_a, y_b, y_c, y_d], axis=-1)
        h = h + mixed @ w_out[l]
        hn = rms_norm(h, ffn_norm_g[l])
        gate, up = jnp.split(hn @ w_ffn_in[l], 2, axis=-1)
        h = h + (jax.nn.silu(gate) * up) @ w_ffn_out[l]
    return h[:, N_META:].astype(x.dtype)
```

```cpp
#include <hip/hip_runtime.h>
#include <hip/hip_cooperative_groups.h>
#include <cstdio>
#include <cmath>
#include <cstring>
namespace cg = cooperative_groups;

typedef unsigned short bf16_t;
typedef short bf16x8 __attribute__((ext_vector_type(8)));
typedef float f32x4 __attribute__((ext_vector_type(4)));
typedef unsigned u32x4 __attribute__((ext_vector_type(4)));
#define DI __device__ __forceinline__
#define MFMA16(a, b, c) __builtin_amdgcn_mfma_f32_16x16x32_bf16((a), (b), (c), 0, 0, 0)

#ifndef MULTI
#define MULTI 0
#endif
#ifndef DBG_NPH
#define DBG_NPH (2 * NPH)
#endif
#ifndef ZB
#define ZB -1
#endif
#ifndef ONLY
#define ONLY -1
#endif

constexpr int NB = 4, TP = 8320, R = NB * TP, NCH = 65, PAD0 = 112;
constexpr int XW = 2304, YW = 3072;
constexpr int NPH = 15;
constexpr float NEGF = -1e30f;
constexpr float LOG2E = 1.4426950408889634f;

constexpr size_t al256(size_t x) { return (x + 255) & ~size_t(255); }
constexpr size_t SZ_WIN = (size_t)(XW + YW) * 1024 * 2, SZ_WUQ = (size_t)768 * 384 * 2, SZ_WUKV = (size_t)1024 * 256 * 2,
                 SZ_WOUT = (size_t)1024 * 2048 * 2, SZ_WFI = (size_t)5632 * 1024 * 2, SZ_WFO = (size_t)1024 * 2816 * 2;
constexpr size_t OFF_WIN = 0, OFF_WUQ = OFF_WIN + al256(SZ_WIN), OFF_WUKV = OFF_WUQ + al256(SZ_WUQ), OFF_WOUT = OFF_WUKV + al256(SZ_WUKV),
                 OFF_WFI = OFF_WOUT + al256(SZ_WOUT), OFF_WFO = OFF_WFI + al256(SZ_WFI), OFF_METAH = OFF_WFO + al256(SZ_WFO),
                 OFF_SCAL = OFF_METAH + al256((size_t)64 * 1024 * 4), OFF_SSDD = OFF_SCAL + 256,
                 OFF_MLG = OFF_SSDD + al256((size_t)64 * NCH * 4), OFF_HN = OFF_MLG + al256((size_t)32 * NCH * 3 * 4);
constexpr size_t SZ_HN = (size_t)R * 1024 * 2;
constexpr size_t OFF_SSDS = OFF_HN;
constexpr size_t OFF_MIXED = OFF_HN + al256(SZ_HN);
constexpr size_t SZ_MIXED = (size_t)R * 2048 * 2;
constexpr size_t OFF_PA = OFF_MIXED, OFF_KNR = OFF_PA + al256((size_t)R * 672 * 2);
constexpr size_t OFF_U = OFF_MIXED + al256(SZ_MIXED);
constexpr size_t OFF_DQKV = OFF_U, OFF_MQ = OFF_DQKV + al256((size_t)R * 1536 * 2), OFF_MK = OFF_MQ + al256((size_t)R * 768 * 2),
                 OFF_MV = OFF_MK + al256((size_t)R * 768 * 2), END_X = OFF_MV + al256((size_t)R * 512 * 2);
constexpr size_t OFF_SZ = OFF_U, OFF_XBCC = OFF_SZ + al256((size_t)R * 512 * 2), OFF_MQKVO = OFF_XBCC + al256((size_t)R * 768 * 2),
                 OFF_GATES = OFF_MQKVO + al256((size_t)R * 1536 * 2), OFF_MLS = OFF_GATES + al256((size_t)R * 32 * 4),
                 END_Y = OFF_MLS + al256((size_t)32 * NCH * 9216 * 4);
constexpr size_t OFF_XBCR = OFF_MLS;
constexpr size_t OFF_ACT = OFF_U, END_F = OFF_ACT + al256((size_t)R * 2816 * 2);
constexpr size_t WS_NEED = (END_X > END_Y ? (END_X > END_F ? END_X : END_F) : (END_Y > END_F ? END_Y : END_F));
static_assert(SZ_HN == (size_t)64 * NCH * 4096 * 4, "ssd states alias hn");
static_assert(OFF_KNR + (size_t)R * 512 * 2 <= OFF_U, "transients fit in mixed");
static_assert((size_t)R * 768 * 2 <= (size_t)32 * NCH * 9216 * 4, "xbc raw fits in mlstm states");

struct Pm {
  const float *x, *meta, *attn_g, *w_in, *q_norm_g, *kv_norm_g, *w_uq, *w_ukv, *q_head_g, *k_head_g, *mla_out_g, *conv_w, *conv_b,
      *dt_bias, *a_log, *ssd_d, *ssd_norm_g, *dq_g, *dk_g, *dlam, *dout_g, *i_bias, *f_bias, *ml_out_g, *w_out, *ffn_g, *w_fi, *w_fo;
  float* out;
  char* ws;
  float inv_m[16];
  float inv_d[8];
  float linit[2];
  int ph0, ph1;
};

typedef const Pm __attribute__((address_space(4)))* PmK;
#define LAUNDER(p) asm volatile("" : "+s"(p))
DI int otid() { int t = threadIdx.x; asm volatile("" : "+v"(t)); return t; }
typedef __bf16 bf2_t __attribute__((ext_vector_type(2)));
typedef float f32x2 __attribute__((ext_vector_type(2)));
DI unsigned cvt_pk(float lo, float hi) { f32x2 v = {lo, hi}; bf2_t b = __builtin_convertvector(v, bf2_t); return __builtin_bit_cast(unsigned, b); }
DI bf16_t f2bf(float x) { return (bf16_t)(cvt_pk(x, 0.f) & 0xffffu); }
DI float bf2f(bf16_t b) { return __uint_as_float(((unsigned)b) << 16); }
DI float bflo(unsigned w) { return __uint_as_float(w << 16); }
DI float bfhi(unsigned w) { return __uint_as_float(w & 0xffff0000u); }
DI void st_bf4(bf16_t* dst, f32x4 v) { uint2 w; w.x = cvt_pk(v[0], v[1]); w.y = cvt_pk(v[2], v[3]); *(uint2*)dst = w; }
DI f32x4 ld_bf4(const bf16_t* src) { uint2 w = *(const uint2*)src; f32x4 v; v[0] = bflo(w.x); v[1] = bfhi(w.x); v[2] = bflo(w.y); v[3] = bfhi(w.y); return v; }
DI void ld_bf8(const bf16_t* src, float* v) { uint4 w = *(const uint4*)src; v[0] = bflo(w.x); v[1] = bfhi(w.x); v[2] = bflo(w.y); v[3] = bfhi(w.y); v[4] = bflo(w.z); v[5] = bfhi(w.z); v[6] = bflo(w.w); v[7] = bfhi(w.w); }
DI void st_bf8(bf16_t* dst, const float* v) { uint4 w; w.x = cvt_pk(v[0], v[1]); w.y = cvt_pk(v[2], v[3]); w.z = cvt_pk(v[4], v[5]); w.w = cvt_pk(v[6], v[7]); *(uint4*)dst = w; }
DI float wsum(float v) { for (int m = 32; m >= 1; m >>= 1) v += __shfl_xor(v, m); return v; }
DI float wmax(float v) { for (int m = 32; m >= 1; m >>= 1) v = fmaxf(v, __shfl_xor(v, m)); return v; }
DI float fexp(float x) { return __builtin_amdgcn_exp2f(x * LOG2E); }
DI float siluf(float x) { return x / (1.f + fexp(-x)); }
DI float sigmf(float x) { return 1.f / (1.f + fexp(-x)); }
DI float softplusf(float x) { return x > 20.f ? x : log1pf(__expf(x)); }
DI float* hrow2(float* out, float* metah, int r) {
  const int b = r / TP, pp = r - b * TP;
  if (pp < PAD0) return nullptr;
  if (pp < 128) return metah + (size_t)(b * 16 + pp - PAD0) * 1024;
  return out + ((size_t)b * 8192 + pp - 128) * 1024;
}
DI float* hrow(PmK p, int r) { return hrow2(p->out, (float*)(p->ws + OFF_METAH), r); }
DI void sincos_rev(float ang, float& c, float& s) {
  double rev = (double)ang * 0.15915494309189535; rev -= rint(rev); const float f = (float)rev;
  s = __builtin_amdgcn_sinf(f); c = __builtin_amdgcn_cosf(f);
}
DI f32x4 mma_lds(const bf16_t* X, int ldx, const bf16_t* Y, int ldy, int K, f32x4 acc, int fr, int fq) {
  for (int k0 = 0; k0 < K; k0 += 32) {
    const bf16x8 x = *(const bf16x8*)(X + fr * ldx + k0 + fq * 8), y = *(const bf16x8*)(Y + fr * ldy + k0 + fq * 8);
    acc = MFMA16(x, y, acc);
  }
  __builtin_amdgcn_sched_barrier(0);
  return acc;
}
DI void scan128_sum(const float* v, float* cum, int dir, int lane) {
  const int i0 = 2 * lane, n0 = dir ? 127 - i0 : i0, n1 = dir ? 126 - i0 : i0 + 1;
  const float a = v[n0], b = a + v[n1]; float s = b;
  for (int d = 1; d < 64; d <<= 1) { const float t = __shfl_up(s, d); if (lane >= d) s += t; }
  const float ex = s - b; cum[n0] = ex + a; cum[n1] = ex + b;
}
DI void scan128_max(const float* v, float* cum, int dir, int lane) {
  const int i0 = 2 * lane, n0 = dir ? 127 - i0 : i0, n1 = dir ? 126 - i0 : i0 + 1;
  const float a = v[n0], b = fmaxf(a, v[n1]); float s = b;
  for (int d = 1; d < 64; d <<= 1) { const float t = __shfl_up(s, d); if (lane >= d) s = fmaxf(s, t); }
  float ex = __shfl_up(s, 1); if (lane == 0) ex = NEGF * 3.f;
  cum[n0] = fmaxf(ex, a); cum[n1] = fmaxf(ex, b);
}

DI int map_in(int n) {
  if (n < 672) return n;
  if (n < 1184) return XW + (n - 672);
  if (n < 1952) return XW + 512 + (n - 1184);
  if (n < 1968) return XW + 2816 + (n - 1952);
  if (n < 3504) return 672 + (n - 1968);
  if (n < 5040) return XW + 1280 + (n - 3504);
  return XW + 2832 + (n - 5040);
}
DI int map_fi(int n) { const int half = n >= 2816, j = n - half * 2816; return 256 * (j >> 7) + half * 128 + (j & 127); }
template <int MODE>
DI void wtrans(char* lds, const float* __restrict__ W, int K, int N, const float* __restrict__ g, bf16_t* __restrict__ Wt) {
  float* tl = (float*)lds;
  const int tid = otid(), nkt = K / 64, nnt = N / 64;
  for (int t = blockIdx.x; t < nkt * nnt; t += gridDim.x) {
    const int kt = t % nkt, nt = t / nkt;
    __syncthreads();
#pragma unroll
    for (int i = 0; i < 8; ++i) {
      const int k = (tid >> 6) + 8 * i, n = tid & 63;
      float v = W[(size_t)(kt * 64 + k) * N + nt * 64 + n];
      if (g) v *= g[kt * 64 + k];
      tl[k * 65 + n] = v;
    }
    __syncthreads();
#pragma unroll
    for (int i = 0; i < 8; ++i) {
      const int n = (tid >> 6) + 8 * i, k = tid & 63, gn = nt * 64 + n;
      const int dst = MODE == 1 ? map_in(gn) : MODE == 2 ? map_fi(gn) : gn;
      Wt[(size_t)dst * K + kt * 64 + k] = f2bf(tl[k * 65 + n]);
    }
  }
}

DI void norm_rows(PmK p, bool first) {
  LAUNDER(p);
  const int tid_ = otid(), wid = tid_ >> 6, lane = tid_ & 63;
  bf16_t* hn = (bf16_t*)(p->ws + OFF_HN);
  for (int r = blockIdx.x * 8 + wid; r < R; r += gridDim.x * 8) {
    const int b = r / TP, pp = r - b * TP;
    bf16_t* dst = hn + (size_t)r * 1024;
    if (pp < PAD0) {
      const uint4 z = {0u, 0u, 0u, 0u};
      *(uint4*)(dst + lane * 16) = z; *(uint4*)(dst + lane * 16 + 8) = z;
      continue;
    }
    float* hr = hrow(p, r);
    const float* src = first ? (pp < 128 ? p->meta + (size_t)(pp - PAD0) * 1024 : p->x + ((size_t)b * 8192 + pp - 128) * 1024) : hr;
    f32x4 v[4]; float ss = 0.f;
#pragma unroll
    for (int i = 0; i < 4; ++i) { v[i] = *(const f32x4*)(src + i * 256 + lane * 4); ss += v[i][0] * v[i][0] + v[i][1] * v[i][1] + v[i][2] * v[i][2] + v[i][3] * v[i][3]; }
    ss = wsum(ss);
    const float rinv = rsqrtf(ss * (1.f / 1024.f) + 1e-6f);
#pragma unroll
    for (int i = 0; i < 4; ++i) {
      if (first) *(f32x4*)(hr + i * 256 + lane * 4) = v[i];
      st_bf4(dst + i * 256 + lane * 4, v[i] * rinv);
    }
  }
}

DI void phase_prep(PmK p, int l, char* lds) {
  LAUNDER(p);
  char* ws = p->ws;
  wtrans<1>(lds, p->w_in + (size_t)l * 1024 * 5056, 1024, 5056, p->attn_g + l * 1024, (bf16_t*)(ws + OFF_WIN));
  wtrans<0>(lds, p->w_uq + (size_t)l * 384 * 768, 384, 768, p->q_norm_g + l * 384, (bf16_t*)(ws + OFF_WUQ));
  wtrans<0>(lds, p->w_ukv + (size_t)l * 256 * 1024, 256, 1024, p->kv_norm_g + l * 256, (bf16_t*)(ws + OFF_WUKV));
  wtrans<0>(lds, p->w_out + (size_t)l * 2048 * 1024, 2048, 1024, nullptr, (bf16_t*)(ws + OFF_WOUT));
  wtrans<2>(lds, p->w_fi + (size_t)l * 1024 * 5632, 1024, 5632, p->ffn_g + l * 1024, (bf16_t*)(ws + OFF_WFI));
  wtrans<0>(lds, p->w_fo + (size_t)l * 2816 * 1024, 2816, 1024, nullptr, (bf16_t*)(ws + OFF_WFO));
  bf16_t* win = (bf16_t*)(ws + OFF_WIN);
  for (int i = blockIdx.x * 512 + threadIdx.x; i < (96 + 224) * 1024; i += gridDim.x * 512) {
    const int row = i >> 10, k = i & 1023;
    const int dst = row < 96 ? 2208 + row : XW + 2848 + (row - 96);
    win[(size_t)dst * 1024 + k] = 0;
  }
  if (blockIdx.x == 0 && threadIdx.x < 64) {
    const float* lam = p->dlam + l * 256; const int t = threadIdx.x;
    const float s1 = wsum(lam[t] * lam[64 + t]), s2 = wsum(lam[128 + t] * lam[192 + t]);
    if (t == 0) ((float*)(ws + OFF_SCAL))[0] = expf(s1) - expf(s2) + p->linit[l];
  }
  norm_rows(p, l == 0);
}

template <class Epi>
DI void gemm_simple(char* lds, const bf16_t* __restrict__ A, int lda, const bf16_t* __restrict__ Bt, int ldb, int nM, int nN, int K, const Epi& epi) {
  const int tid = otid(), wid = tid >> 6, lane = tid & 63, wr = wid >> 2, wc = wid & 3, fr = lane & 15, fq = lane >> 4;
  bf16_t* As = (bf16_t*)lds; bf16_t* Bs = As + 256 * 72;
  for (int tile = blockIdx.x; tile < nM * nN; tile += gridDim.x) {
    const int pm = tile / nN, pn = tile - pm * nN;
    f32x4 acc[2][2][4][2];
#pragma unroll
    for (int a = 0; a < 2; ++a)
#pragma unroll
      for (int b = 0; b < 2; ++b)
#pragma unroll
        for (int m = 0; m < 4; ++m)
#pragma unroll
          for (int n = 0; n < 2; ++n) acc[a][b][m][n] = (f32x4){0.f, 0.f, 0.f, 0.f};
    const bf16_t* Ab = A + (size_t)pm * 256 * lda + (size_t)(tid >> 3) * lda + (tid & 7) * 8;
    const bf16_t* Bb = Bt + (size_t)pn * 256 * ldb + (size_t)(tid >> 3) * ldb + (tid & 7) * 8;
    bf16_t* const Asw = As + (tid >> 3) * 72 + (tid & 7) * 8; bf16_t* const Bsw = Bs + (tid >> 3) * 72 + (tid & 7) * 8;
    bf16x8 ra[4], rb[4];
#pragma unroll
    for (int i = 0; i < 4; ++i) { ra[i] = *(const bf16x8*)(Ab + (size_t)i * 64 * lda); rb[i] = *(const bf16x8*)(Bb + (size_t)i * 64 * ldb); }
#pragma unroll 1
    for (int k0 = 0; k0 < K; k0 += 64) {
      __syncthreads();
#pragma unroll
      for (int i = 0; i < 4; ++i) { *(bf16x8*)(Asw + i * 64 * 72) = ra[i]; *(bf16x8*)(Bsw + i * 64 * 72) = rb[i]; }
      __syncthreads();
      if (k0 + 64 < K) {
        Ab += 64; Bb += 64;
#pragma unroll
        for (int i = 0; i < 4; ++i) { ra[i] = *(const bf16x8*)(Ab + (size_t)i * 64 * lda); rb[i] = *(const bf16x8*)(Bb + (size_t)i * 64 * ldb); }
      }
#pragma unroll
      for (int ks = 0; ks < 2; ++ks) {
        bf16x8 bfr[2][2];
#pragma unroll
        for (int bj = 0; bj < 2; ++bj)
#pragma unroll
          for (int n = 0; n < 2; ++n) bfr[bj][n] = *(const bf16x8*)(Bs + (128 * bj + 32 * wc + 16 * n + fr) * 72 + ks * 32 + fq * 8);
#pragma unroll
        for (int ai = 0; ai < 2; ++ai) {
          bf16x8 af[4];
#pragma unroll
          for (int m = 0; m < 4; ++m) af[m] = *(const bf16x8*)(As + (128 * ai + 64 * wr + 16 * m + fr) * 72 + ks * 32 + fq * 8);
#pragma unroll
          for (int bj = 0; bj < 2; ++bj)
#pragma unroll
            for (int m = 0; m < 4; ++m)
#pragma unroll
              for (int n = 0; n < 2; ++n) acc[ai][bj][m][n] = MFMA16(bfr[bj][n], af[m], acc[ai][bj][m][n]);
        }
      }
    }
    epi(acc, pm, pn, wr, wc, fr, fq);
  }
  __syncthreads();
}
template <class F>
DI void epi_each(const f32x4 (&acc)[2][2][4][2], int pm, int pn, int wr, int wc, int fr, int fq, const F& f) {
#pragma unroll
  for (int ai = 0; ai < 2; ++ai)
#pragma unroll
    for (int m = 0; m < 4; ++m) {
      const int row = pm * 256 + 128 * ai + 64 * wr + 16 * m + fr;
#pragma unroll
      for (int bj = 0; bj < 2; ++bj)
#pragma unroll
        for (int n = 0; n < 2; ++n) f(row, pn * 256 + 128 * bj + 32 * wc + 16 * n + 4 * fq, acc[ai][bj][m][n]);
    }
}

DI void phase_p2x(PmK p, int l) {
  LAUNDER(p);
  const int tid_ = otid(), wid = tid_ >> 6, lane = tid_ & 63;
  bf16_t* dqkv = (bf16_t*)(p->ws + OFF_DQKV);
  const int hd = lane >> 2, part = lane & 3;
  const float* g = (hd < 8 ? p->dq_g : p->dk_g) + l * 64 + part * 16;
  float gv[16];
#pragma unroll
  for (int e = 0; e < 16; ++e) gv[e] = g[e];
  const float qs = hd < 8 ? 0.125f * LOG2E : 1.f;
  for (int r = blockIdx.x * 8 + wid; r < R; r += gridDim.x * 8) {
    const int b = r / TP, pp = r - b * TP;
    bf16_t* ptr = dqkv + (size_t)r * 1536 + lane * 16;
    float v[16]; ld_bf8(ptr, v); ld_bf8(ptr + 8, v + 8);
    float ss = 0.f;
#pragma unroll
    for (int e = 0; e < 16; ++e) ss += v[e] * v[e];
    ss += __shfl_xor(ss, 1); ss += __shfl_xor(ss, 2);
    const float rinv = rsqrtf(ss * (1.f / 64.f) + 1e-6f) * qs;
#pragma unroll
    for (int e = 0; e < 16; ++e) v[e] *= rinv * gv[e];
    if (part == 0) {
      const float t = (float)(pp - PAD0);
#pragma unroll
      for (int i = 0; i < 8; ++i) {
        float c, s; sincos_rev(t * p->inv_d[i], c, s);
        const float x1 = v[i], x2 = v[i + 8];
        v[i] = x1 * c - x2 * s; v[i + 8] = x2 * c + x1 * s;
      }
    }
    st_bf8(ptr, v); st_bf8(ptr + 8, v + 8);
  }
}

DI void phase_p3(PmK p, int l, char* lds) {
  LAUNDER(p);
  const int tid_ = otid(), wid = tid_ >> 6, lane = tid_ & 63;
  float* wl = (float*)lds + wid * 2048;
  float* sq = wl; float* sa = wl + 768; float* sk = wl + 1440; float* scs = wl + 1952; float* ssn = wl + 1968;
  bf16_t* mq = (bf16_t*)(p->ws + OFF_MQ); bf16_t* mk = (bf16_t*)(p->ws + OFF_MK); bf16_t* mv = (bf16_t*)(p->ws + OFF_MV);
  const bf16_t* pa = (const bf16_t*)(p->ws + OFF_PA); const bf16_t* knr = (const bf16_t*)(p->ws + OFF_KNR);
  const float* qg = p->q_head_g + l * 96; const float* kg = p->k_head_g + l * 96;
  const float qscale = 0.10206207261596577f * LOG2E;
  const int h = lane >> 3, e0 = (lane & 7) * 12;
  for (int r = blockIdx.x * 8 + wid; r < R; r += gridDim.x * 8) {
    const int b = r / TP, pp = r - b * TP;
    for (int i = lane; i < 192; i += 64) { const f32x4 v = ld_bf4(mq + (size_t)r * 768 + i * 4); *(f32x4*)(sq + i * 4) = v; }
    for (int i = lane; i < 168; i += 64) { const f32x4 v = ld_bf4(pa + (size_t)r * 672 + i * 4); *(f32x4*)(sa + i * 4) = v; }
    for (int i = lane; i < 128; i += 64) { const f32x4 v = ld_bf4(knr + (size_t)r * 512 + i * 4); *(f32x4*)(sk + i * 4) = v; }
    if (lane < 16) { float c, s; sincos_rev((float)(pp - PAD0) * p->inv_m[lane], c, s); scs[lane] = c; ssn[lane] = s; }
    __syncthreads();
    float s1 = 0.f, s2 = 0.f;
    for (int i = lane; i < 384; i += 64) s1 += sa[i] * sa[i];
    for (int i = lane; i < 256; i += 64) s2 += sa[384 + i] * sa[384 + i];
    s1 = wsum(s1); s2 = wsum(s2);
    const float rq = rsqrtf(s1 * (1.f / 384.f) + 1e-6f), rkv = rsqrtf(s2 * (1.f / 256.f) + 1e-6f);
    float ssq = 0.f, ssk = 0.f;
#pragma unroll
    for (int e = 0; e < 12; ++e) {
      const int d = e0 + e; const float qv = sq[h * 96 + d] * rq; ssq += qv * qv;
      const float kv = d < 32 ? sa[640 + d] : sk[h * 64 + d - 32] * rkv; ssk += kv * kv;
    }
    ssq += __shfl_xor(ssq, 1); ssq += __shfl_xor(ssq, 2); ssq += __shfl_xor(ssq, 4);
    ssk += __shfl_xor(ssk, 1); ssk += __shfl_xor(ssk, 2); ssk += __shfl_xor(ssk, 4);
    const float nq = rsqrtf(ssq * (1.f / 96.f) + 1e-6f) * rq * qscale, nk = rsqrtf(ssk * (1.f / 96.f) + 1e-6f);
    float oq[12], ok[12];
#pragma unroll
    for (int e = 0; e < 12; ++e) {
      const int d = e0 + e;
      auto qn = [&](int dd) { return sq[h * 96 + dd] * nq * qg[dd]; };
      auto kn = [&](int dd) { return (dd < 32 ? sa[640 + dd] : sk[h * 64 + dd - 32] * rkv) * nk * kg[dd]; };
      if (d < 16) { oq[e] = qn(d) * scs[d] - qn(d + 16) * ssn[d]; ok[e] = kn(d) * scs[d] - kn(d + 16) * ssn[d]; }
      else if (d < 32) { oq[e] = qn(d) * scs[d - 16] + qn(d - 16) * ssn[d - 16]; ok[e] = kn(d) * scs[d - 16] + kn(d - 16) * ssn[d - 16]; }
      else { oq[e] = qn(d); ok[e] = kn(d); }
    }
    __syncthreads();
    bf16_t* dq = mq + (size_t)r * 768 + lane * 12; bf16_t* dk = mk + (size_t)r * 768 + lane * 12;
#pragma unroll
    for (int e = 0; e < 12; e += 4) { st_bf4(dq + e, (f32x4){oq[e], oq[e + 1], oq[e + 2], oq[e + 3]}); st_bf4(dk + e, (f32x4){ok[e], ok[e + 1], ok[e + 2], ok[e + 3]}); }
    { bf16_t* vp = mv + (size_t)r * 512 + lane * 8; float v[8]; ld_bf8(vp, v);
#pragma unroll
      for (int e = 0; e < 8; ++e) v[e] *= rkv;
      st_bf8(vp, v); }
    __syncthreads();
  }
}

DI void phase_p2y(PmK p, int l) {
  LAUNDER(p);
  const int tid_ = otid(), wid = tid_ >> 6, lane = tid_ & 63;
  const bf16_t* xr = (const bf16_t*)(p->ws + OFF_XBCR); bf16_t* xc = (bf16_t*)(p->ws + OFF_XBCC); float* gates = (float*)(p->ws + OFF_GATES);
  const float* cw = p->conv_w + (size_t)l * 5 * 768; const float* cb = p->conv_b + l * 768;
  const int c0 = lane * 12;
  for (int r = blockIdx.x * 8 + wid; r < R; r += gridDim.x * 8) {
    const int b = r / TP, pp = r - b * TP;
    bf16_t* dst = xc + (size_t)r * 768 + c0;
    if (pp < PAD0) {
      const uint2 z = {0u, 0u};
      *(uint2*)dst = z; *(uint2*)(dst + 4) = z; *(uint2*)(dst + 8) = z;
      if (lane < 32) gates[(size_t)r * 32 + lane] = lane < 16 ? 0.f : (lane < 24 ? NEGF : 0.f);
      continue;
    }
    float acc[12];
#pragma unroll
    for (int e = 0; e < 12; ++e) acc[e] = cb[c0 + e];
#pragma unroll
    for (int j = 0; j < 5; ++j) {
      const int q = pp + j - 2;
      if (q >= PAD0 && q < TP) {
        const bf16_t* src = xr + (size_t)(r + j - 2) * 768 + c0;
#pragma unroll
        for (int e = 0; e < 12; e += 4) { const f32x4 v = ld_bf4(src + e);
          acc[e] += cw[j * 768 + c0 + e] * v[0]; acc[e + 1] += cw[j * 768 + c0 + e + 1] * v[1]; acc[e + 2] += cw[j * 768 + c0 + e + 2] * v[2]; acc[e + 3] += cw[j * 768 + c0 + e + 3] * v[3]; }
      }
    }
#pragma unroll
    for (int e = 0; e < 12; e += 4) st_bf4(dst + e, (f32x4){siluf(acc[e]), siluf(acc[e + 1]), siluf(acc[e + 2]), siluf(acc[e + 3])});
    if (lane < 32) {
      float v = gates[(size_t)r * 32 + lane];
      if (lane < 16) v = softplusf(v + p->dt_bias[l * 16 + lane]);
      else if (lane < 24) v = v + p->i_bias[l * 8 + lane - 16];
      else v = -softplusf(-(v + p->f_bias[l * 8 + lane - 24]));
      gates[(size_t)r * 32 + lane] = v;
    }
  }
}

DI void phase_post(PmK p, int l) {
  LAUNDER(p);
  const int tid_ = otid(), wid = tid_ >> 6, lane = tid_ & 63;
  bf16_t* mixed = (bf16_t*)(p->ws + OFF_MIXED); const bf16_t* sz = (const bf16_t*)(p->ws + OFF_SZ); const bf16_t* mo = (const bf16_t*)(p->ws + OFF_MQKVO);
  const float one_m_l = 1.f - p->linit[l];
  for (int r = blockIdx.x * 8 + wid; r < R; r += gridDim.x * 8) {
    const int b = r / TP, pp = r - b * TP;
    if (pp < PAD0) continue;
    bf16_t* row = mixed + (size_t)r * 2048 + lane * 8;
    float v[8], z[8];
    {
      ld_bf8(row, v); float ss = 0.f;
#pragma unroll
      for (int e = 0; e < 8; ++e) ss += v[e] * v[e];
      ss = wsum(ss); const float rn = rsqrtf(ss * (1.f / 512.f) + 1e-6f);
#pragma unroll
      for (int e = 0; e < 8; ++e) v[e] *= rn * p->mla_out_g[l * 512 + lane * 8 + e];
      if (ZB == 0) { for (int e = 0; e < 8; ++e) v[e] = 0.f; }
      st_bf8(row, v);
    }
    {
      ld_bf8(row + 512, v); ld_bf8(sz + (size_t)r * 512 + lane * 8, z); float ss = 0.f;
#pragma unroll
      for (int e = 0; e < 8; ++e) { v[e] *= siluf(z[e]); ss += v[e] * v[e]; }
      ss = wsum(ss); const float rn = rsqrtf(ss * (1.f / 512.f) + 1e-6f);
#pragma unroll
      for (int e = 0; e < 8; ++e) v[e] *= rn * p->ssd_norm_g[l * 512 + lane * 8 + e];
      if (ZB == 1) { for (int e = 0; e < 8; ++e) v[e] = 0.f; }
      st_bf8(row + 512, v);
    }
    {
      ld_bf8(row + 1024, v); float ss = 0.f;
#pragma unroll
      for (int e = 0; e < 8; ++e) ss += v[e] * v[e];
      ss += __shfl_xor(ss, 1); ss += __shfl_xor(ss, 2); ss += __shfl_xor(ss, 4); ss += __shfl_xor(ss, 8);
      const float rn = rsqrtf(ss * (1.f / 128.f) + 1e-6f) * one_m_l;
#pragma unroll
      for (int e = 0; e < 8; ++e) v[e] *= rn * p->dout_g[l * 128 + (lane & 15) * 8 + e];
      if (ZB == 2) { for (int e = 0; e < 8; ++e) v[e] = 0.f; }
      st_bf8(row + 1024, v);
    }
    {
      ld_bf8(row + 1536, v); ld_bf8(mo + (size_t)r * 1536 + 1024 + lane * 8, z); float ss = 0.f;
#pragma unroll
      for (int e = 0; e < 8; ++e) ss += v[e] * v[e];
      ss += __shfl_xor(ss, 1); ss += __shfl_xor(ss, 2); ss += __shfl_xor(ss, 4); ss += __shfl_xor(ss, 8);
      const float rn = rsqrtf(ss * (1.f / 128.f) + 1e-6f);
#pragma unroll
      for (int e = 0; e < 8; ++e) v[e] *= rn * p->ml_out_g[l * 128 + (lane & 15) * 8 + e] * sigmf(z[e]);
      if (ZB == 3) { for (int e = 0; e < 8; ++e) v[e] = 0.f; }
      st_bf8(row + 1536, v);
    }
  }
}

template <int DQK, int DV>
DI void attn_pass(char* lds, const bf16_t* __restrict__ Qb, int ldq, const bf16_t* __restrict__ Kb, int ldk, const bf16_t* __restrict__ Vb, int ldv,
                  int q0, f32x4 (&o)[DV / 16]) {
  constexpr int KS = DQK + 8, VS = 72, NKQ = DQK / 32, NDB = DV / 16, KCH = DQK / 8, VCH = DV / 8;
  constexpr int NKC = 64 * KCH, NVC = 64 * VCH, KI = (NKC + 511) / 512, VI = (NVC + 511) / 512, NT = TP / 64;
  bf16_t* Ks = (bf16_t*)lds; bf16_t* Vt = Ks + 64 * KS;
  const int tid = otid(), wid = tid >> 6, lane = tid & 63, fr = lane & 15, fq = lane >> 4;
  bf16x8 qf[NKQ];
  const bf16_t* qrow = Qb + (size_t)(q0 + 16 * wid + fr) * ldq;
#pragma unroll
  for (int ks = 0; ks < NKQ; ++ks) qf[ks] = *(const bf16x8*)(qrow + ks * 32 + fq * 8);
#pragma unroll
  for (int db = 0; db < NDB; ++db) o[db] = (f32x4){0.f, 0.f, 0.f, 0.f};
  float m = NEGF, lsum = 0.f;
  bf16x8 rk[KI], rv[VI];
#define ATT_GLOAD(kt) do { const int p0_ = (kt) * 64; \
    _Pragma("unroll") for (int i = 0; i < KI; ++i) { const int id = tid + 512 * i; if (id < NKC) { const int row = id / KCH, c = id - row * KCH; rk[i] = *(const bf16x8*)(Kb + (size_t)(p0_ + row) * ldk + c * 8); } } \
    _Pragma("unroll") for (int i = 0; i < VI; ++i) { const int id = tid + 512 * i; if (id < NVC) { const int row = id / VCH, c = id - row * VCH; rv[i] = *(const bf16x8*)(Vb + (size_t)(p0_ + row) * ldv + c * 8); } } } while (0)
  ATT_GLOAD(1);
  for (int kt = 1; kt < NT; ++kt) {
    __syncthreads();
#pragma unroll
    for (int i = 0; i < KI; ++i) { const int id = tid + 512 * i; if (id < NKC) { const int row = id / KCH, c = id - row * KCH; *(bf16x8*)(Ks + row * KS + c * 8) = rk[i]; } }
#pragma unroll
    for (int i = 0; i < VI; ++i) { const int id = tid + 512 * i; if (id < NVC) { const int row = id / VCH, c = id - row * VCH;
#pragma unroll
        for (int e = 0; e < 8; ++e) Vt[(c * 8 + e) * VS + row] = (bf16_t)rv[i][e]; } }
    __syncthreads();
    if (kt + 1 < NT) ATT_GLOAD(kt + 1);
    f32x4 s[4];
#pragma unroll
    for (int kb = 0; kb < 4; ++kb) {
      s[kb] = (f32x4){0.f, 0.f, 0.f, 0.f};
#pragma unroll
      for (int ks = 0; ks < NKQ; ++ks) { const bf16x8 kf = *(const bf16x8*)(Ks + (kb * 16 + fr) * KS + ks * 32 + fq * 8); s[kb] = MFMA16(kf, qf[ks], s[kb]); }
    }
    if (kt == 1) {
#pragma unroll
      for (int kb = 0; kb < 4; ++kb)
#pragma unroll
        for (int j = 0; j < 4; ++j) if (kb * 16 + 4 * fq + j < 48) s[kb][j] = NEGF;
    }
    float mx = NEGF;
#pragma unroll
    for (int kb = 0; kb < 4; ++kb)
#pragma unroll
      for (int j = 0; j < 4; ++j) mx = fmaxf(mx, s[kb][j]);
    mx = fmaxf(mx, __shfl_xor(mx, 16)); mx = fmaxf(mx, __shfl_xor(mx, 32));
    const float mn = fmaxf(m, mx), alpha = __builtin_amdgcn_exp2f(m - mn); m = mn;
    float rs = 0.f;
#pragma unroll
    for (int kb = 0; kb < 4; ++kb)
#pragma unroll
      for (int j = 0; j < 4; ++j) { s[kb][j] = __builtin_amdgcn_exp2f(s[kb][j] - mn); rs += s[kb][j]; }
    lsum = lsum * alpha + rs;
#pragma unroll
    for (int db = 0; db < NDB; ++db) o[db] *= alpha;
    bf16x8 pf[2];
#pragma unroll
    for (int kk = 0; kk < 2; ++kk) {
      u32x4 w = {cvt_pk(s[2 * kk][0], s[2 * kk][1]), cvt_pk(s[2 * kk][2], s[2 * kk][3]), cvt_pk(s[2 * kk + 1][0], s[2 * kk + 1][1]), cvt_pk(s[2 * kk + 1][2], s[2 * kk + 1][3])};
      pf[kk] = __builtin_bit_cast(bf16x8, w);
    }
#pragma unroll
    for (int db = 0; db < NDB; ++db)
#pragma unroll
      for (int kk = 0; kk < 2; ++kk) {
        const bf16_t* vp = Vt + (db * 16 + fr) * VS + kk * 32 + 4 * fq;
        const uint2 a = *(const uint2*)vp, b = *(const uint2*)(vp + 16);
        u32x4 w = {a.x, a.y, b.x, b.y};
        o[db] = MFMA16(__builtin_bit_cast(bf16x8, w), pf[kk], o[db]);
      }
  }
#undef ATT_GLOAD
  lsum += __shfl_xor(lsum, 16); lsum += __shfl_xor(lsum, 32);
  const float il = 1.f / lsum;
#pragma unroll
  for (int db = 0; db < NDB; ++db) o[db] *= il;
  __syncthreads();
}

DI void phase_attn(PmK p, char* lds) {
  LAUNDER(p);
  const int tid = otid(), wid = tid >> 6, lane = tid & 63, fr = lane & 15, fq = lane >> 4;
  bf16_t* mixed = (bf16_t*)(p->ws + OFF_MIXED);
  const bf16_t* dqkv = (const bf16_t*)(p->ws + OFF_DQKV);
  const bf16_t* mq = (const bf16_t*)(p->ws + OFF_MQ); const bf16_t* mk = (const bf16_t*)(p->ws + OFF_MK); const bf16_t* mv = (const bf16_t*)(p->ws + OFF_MV);
  const float lam = ((const float*)(p->ws + OFF_SCAL))[0];
  constexpr int ND = NB * 4 * NCH, NM = NB * 8 * NCH;
  for (int it = blockIdx.x; it < ND + NM; it += gridDim.x) {
    if (it < ND) {
      const int qt = it % NCH, bh = it / NCH, h = bh & 3, b = bh >> 2;
      const bf16_t* base = dqkv + (size_t)b * TP * 1536;
      f32x4 o1[8], o2[8];
      attn_pass<64, 128>(lds, base + (2 * h) * 64, 1536, base + 512 + (2 * h) * 64, 1536, base + 1024 + h * 128, 1536, qt * 128, o1);
      attn_pass<64, 128>(lds, base + (2 * h + 1) * 64, 1536, base + 512 + (2 * h + 1) * 64, 1536, base + 1024 + h * 128, 1536, qt * 128, o2);
      const int pp = qt * 128 + 16 * wid + fr;
      bf16_t* dst = mixed + ((size_t)b * TP + pp) * 2048 + 1024 + h * 128 + 4 * fq;
#pragma unroll
      for (int db = 0; db < 8; ++db) st_bf4(dst + db * 16, o1[db] - lam * o2[db]);
    } else {
      const int i2 = it - ND, qt = i2 % NCH, bh = i2 / NCH, h = bh & 7, b = bh >> 3;
      f32x4 o[4];
      attn_pass<96, 64>(lds, mq + (size_t)b * TP * 768 + h * 96, 768, mk + (size_t)b * TP * 768 + h * 96, 768, mv + (size_t)b * TP * 512 + h * 64, 512, qt * 128, o);
      const int pp = qt * 128 + 16 * wid + fr;
      bf16_t* dst = mixed + ((size_t)b * TP + pp) * 2048 + h * 64 + 4 * fq;
#pragma unroll
      for (int db = 0; db < 4; ++db) st_bf4(dst + db * 16, o[db]);
    }
  }
}

DI void phase_states(PmK p, int l, char* lds) {
  LAUNDER(p);
  const int tid = otid(), wid = tid >> 6, lane = tid & 63, fr = lane & 15, fq = lane >> 4;
  const bf16_t* xc = (const bf16_t*)(p->ws + OFF_XBCC); const float* gates = (const float*)(p->ws + OFF_GATES);
  const bf16_t* mqk = (const bf16_t*)(p->ws + OFF_MQKVO);
  float* ssds = (float*)(p->ws + OFF_SSDS); float* ssdd = (float*)(p->ws + OFF_SSDD);
  float* mls = (float*)(p->ws + OFF_MLS); float* mlg = (float*)(p->ws + OFF_MLG);
  bf16_t* T0 = (bf16_t*)lds;
  bf16_t* T1 = T0 + 64 * 136;
  float* s_a = (float*)(T1 + 144 * 136); float* s_b = s_a + 128; float* s_cum = s_b + 128; float* s_sc = s_cum + 128;
  constexpr int NS = NB * NCH * 8 * 2, NMI = NB * NCH * 4 * 2;
  for (int it = blockIdx.x; it < NS + NMI; it += gridDim.x) {
    __syncthreads();
    if (it < NS) {
      const int dir = it & 1, hh = (it >> 1) & 7, bc = it >> 4, c = bc % NCH, b = bc / NCH, g = hh >> 2;
      const int r0 = b * TP + c * 128;
      const float Ah = -expf(p->a_log[l * 16 + dir * 8 + hh]);
      if (tid < 128) { const float dtv = gates[(size_t)(r0 + tid) * 32 + dir * 8 + hh]; s_b[tid] = dtv; s_a[tid] = dtv * Ah; }
      __syncthreads();
      if (wid == 0) scan128_sum(s_a, s_cum, dir, lane);
      __syncthreads();
      const float tot = dir ? s_cum[0] : s_cum[127];
#pragma unroll
      for (int i = 0; i < 2; ++i) {
        const int id = tid + 512 * i, lrow = id >> 3, c8 = id & 7;
        float xv[8]; ld_bf8(xc + (size_t)(r0 + lrow) * 768 + hh * 64 + c8 * 8, xv);
        const uint4 bw = *(const uint4*)(xc + (size_t)(r0 + lrow) * 768 + 512 + g * 64 + c8 * 8);
        const bf16x8 bv = __builtin_bit_cast(bf16x8, bw);
        const float sc = s_b[lrow] * fexp(tot - s_cum[lrow]);
#pragma unroll
        for (int e = 0; e < 8; ++e) { T0[(c8 * 8 + e) * 136 + lrow] = f2bf(xv[e] * sc); T1[(c8 * 8 + e) * 136 + lrow] = (bf16_t)bv[e]; }
      }
      __syncthreads();
      const int cp = dir ? NCH - 1 - c : c;
      const size_t sidx = (size_t)((b * 8 + hh) * 2 + dir) * NCH + cp;
      for (int t = wid; t < 16; t += 8) {
        const int nt = t & 3, pt = t >> 2;
        const f32x4 acc = mma_lds(T1 + nt * 16 * 136, 136, T0 + pt * 16 * 136, 136, 128, (f32x4){0.f, 0.f, 0.f, 0.f}, fr, fq);
        *(f32x4*)(ssds + sidx * 4096 + (pt * 16 + fr) * 64 + nt * 16 + 4 * fq) = acc;
      }
      if (tid == 0) ssdd[sidx] = fexp(tot);
    } else {
      const int i2 = it - NS, dir = i2 & 1, hm = (i2 >> 1) & 3, bc = i2 >> 3, c = bc % NCH, b = bc / NCH;
      const int r0 = b * TP + c * 128;
      if (tid < 128) { s_a[tid] = gates[(size_t)(r0 + tid) * 32 + 24 + dir * 4 + hm]; s_b[tid] = gates[(size_t)(r0 + tid) * 32 + 16 + dir * 4 + hm]; }
      __syncthreads();
      if (wid == 0) scan128_sum(s_a, s_cum, dir, lane);
      __syncthreads();
      const float glast = dir ? s_cum[0] : s_cum[127];
      if (wid == 0) {
        float mx = fmaxf(glast - s_cum[lane] + s_b[lane], glast - s_cum[lane + 64] + s_b[lane + 64]);
        mx = wmax(mx); if (lane == 0) s_sc[0] = mx;
      }
      __syncthreads();
      const float mloc = s_sc[0];
#pragma unroll
      for (int i = 0; i < 2; ++i) {
        const int id = tid + 512 * i, lrow = id >> 3, c8 = id & 7;
        const uint4 kw = *(const uint4*)(mqk + (size_t)(r0 + lrow) * 1536 + 256 + hm * 64 + c8 * 8);
        const bf16x8 kv = __builtin_bit_cast(bf16x8, kw);
#pragma unroll
        for (int e = 0; e < 8; ++e) T0[(c8 * 8 + e) * 136 + lrow] = (bf16_t)kv[e];
      }
#pragma unroll
      for (int i = 0; i < 4; ++i) {
        const int id = tid + 512 * i, lrow = id >> 4, c8 = id & 15;
        float vv[8]; ld_bf8(mqk + (size_t)(r0 + lrow) * 1536 + 512 + hm * 128 + c8 * 8, vv);
        const float w = fexp(glast - s_cum[lrow] + s_b[lrow] - mloc);
#pragma unroll
        for (int e = 0; e < 8; ++e) T1[(c8 * 8 + e) * 136 + lrow] = f2bf(vv[e] * w);
      }
      for (int id = tid; id < 16 * 128; id += 512) {
        const int vr = id >> 7, lrow = id & 127;
        T1[(128 + vr) * 136 + lrow] = vr == 0 ? f2bf(fexp(glast - s_cum[lrow] + s_b[lrow] - mloc)) : (bf16_t)0;
      }
      __syncthreads();
      const int cp = dir ? NCH - 1 - c : c;
      const size_t sidx = (size_t)((b * 4 + hm) * 2 + dir) * NCH + cp;
      for (int t = wid; t < 36; t += 8) {
        const int dt_ = t & 3, vt = t >> 2;
        const f32x4 acc = mma_lds(T0 + dt_ * 16 * 136, 136, T1 + vt * 16 * 136, 136, 128, (f32x4){0.f, 0.f, 0.f, 0.f}, fr, fq);
        *(f32x4*)(mls + sidx * 9216 + (vt * 16 + fr) * 64 + dt_ * 16 + 4 * fq) = acc;
      }
      if (tid == 0) { mlg[sidx * 3] = glast; mlg[sidx * 3 + 1] = mloc; }
    }
  }
  __syncthreads();
}

DI void phase_scan(PmK p) {
  LAUNDER(p);
  float* ssds = (float*)(p->ws + OFF_SSDS); const float* ssdd = (const float*)(p->ws + OFF_SSDD);
  float* mls = (float*)(p->ws + OFF_MLS); float* mlg = (float*)(p->ws + OFF_MLG);
  const int gt = blockIdx.x * 512 + threadIdx.x, gn = gridDim.x * 512;
  for (int e = gt; e < 64 * 4096; e += gn) {
    const int chain = e >> 12, el = e & 4095; float run = 0.f;
    for (int cp = 0; cp < NCH; ++cp) {
      const size_t ix = (size_t)(chain * NCH + cp) * 4096 + el;
      const float t = ssds[ix]; ssds[ix] = run; run = run * ssdd[chain * NCH + cp] + t;
    }
  }
  for (int e = gt; e < 32 * 9216; e += gn) {
    const int chain = e / 9216, el = e - chain * 9216; float run = 0.f, m = NEGF;
    for (int cp = 0; cp < NCH; ++cp) {
      const int ci = chain * NCH + cp; const size_t ix = (size_t)ci * 9216 + el;
      const float gl = mlg[ci * 3], ml = mlg[ci * 3 + 1];
      const float t = mls[ix]; mls[ix] = run;
      if (el == 0) mlg[ci * 3 + 2] = m;
      const float mn = fmaxf(gl + m, ml);
      run = fexp(gl + m - mn) * run + fexp(ml - mn) * t; m = mn;
    }
  }
}

DI void phase_out(PmK p, int l, char* lds) {
  LAUNDER(p);
  const int tid = otid(), wid = tid >> 6, lane = tid & 63, fr = lane & 15, fq = lane >> 4;
  const bf16_t* xc = (const bf16_t*)(p->ws + OFF_XBCC); const float* gates = (const float*)(p->ws + OFF_GATES);
  const bf16_t* mqk = (const bf16_t*)(p->ws + OFF_MQKVO);
  const float* ssds = (const float*)(p->ws + OFF_SSDS); const float* mls = (const float*)(p->ws + OFF_MLS); const float* mlg = (const float*)(p->ws + OFF_MLG);
  bf16_t* mixed = (bf16_t*)(p->ws + OFF_MIXED);
  bf16_t* A0 = (bf16_t*)lds; bf16_t* A1 = A0 + 128 * 72; bf16_t* Vt = A1 + 128 * 72; bf16_t* Ms = Vt + 144 * 136; bf16_t* St = Ms + 128 * 136;
  float* s_a = (float*)(St + 144 * 72); float* s_b = s_a + 128; float* s_cum = s_b + 128; float* s_pm = s_cum + 128;
  constexpr int NS = NB * NCH * 8, NMI = NB * NCH * 4;
  const f32x4 zero4 = {0.f, 0.f, 0.f, 0.f};
  for (int it = blockIdx.x; it < NS; it += gridDim.x) {
    __syncthreads();
    {
      const int hh = it & 7, bc = it >> 3, c = bc % NCH, b = bc / NCH, g = hh >> 2;
      const int r0 = b * TP + c * 128;
#pragma unroll
      for (int i = 0; i < 2; ++i) {
        const int id = tid + 512 * i, lrow = id >> 3, c8 = id & 7;
        *(uint4*)(A0 + lrow * 72 + c8 * 8) = *(const uint4*)(xc + (size_t)(r0 + lrow) * 768 + 640 + g * 64 + c8 * 8);
        *(uint4*)(A1 + lrow * 72 + c8 * 8) = *(const uint4*)(xc + (size_t)(r0 + lrow) * 768 + 512 + g * 64 + c8 * 8);
      }
      __syncthreads();
      f32x4 yacc[4] = {zero4, zero4, zero4, zero4};
      const int lrow_me = 16 * wid + fr;
      for (int dir = 0; dir < 2; ++dir) {
        __syncthreads();
        const float Ah = -expf(p->a_log[l * 16 + dir * 8 + hh]);
        if (tid < 128) { const float dtv = gates[(size_t)(r0 + tid) * 32 + dir * 8 + hh]; s_b[tid] = dtv; s_a[tid] = dtv * Ah; }
        __syncthreads();
        if (wid == 0) scan128_sum(s_a, s_cum, dir, lane);
        __syncthreads();
#pragma unroll
        for (int i = 0; i < 2; ++i) {
          const int id = tid + 512 * i, lrow = id >> 3, c8 = id & 7;
          float xv[8]; ld_bf8(xc + (size_t)(r0 + lrow) * 768 + hh * 64 + c8 * 8, xv);
          const float sc = s_b[lrow];
#pragma unroll
          for (int e = 0; e < 8; ++e) Vt[(c8 * 8 + e) * 136 + lrow] = f2bf(xv[e] * sc);
        }
        const int cp = dir ? NCH - 1 - c : c;
        const size_t sidx = (size_t)((b * 8 + hh) * 2 + dir) * NCH + cp;
#pragma unroll
        for (int i = 0; i < 2; ++i) {
          const int id = tid + 512 * i;
          const f32x4 v = *(const f32x4*)(ssds + sidx * 4096 + id * 4);
          st_bf4(St + (id >> 4) * 72 + (id & 15) * 4, v);
        }
        const float cl = s_cum[lrow_me];
        int lrow_v = lrow_me; asm volatile("" : "+v"(lrow_v));
#pragma unroll 1
        for (int st = 0; st < 8; ++st) {
          f32x4 mv;
          const f32x4 gt_ = mma_lds(A1 + st * 16 * 72, 72, A0 + wid * 16 * 72, 72, 64, zero4, fr, fq);
#pragma unroll
          for (int j = 0; j < 4; ++j) {
            const int s = 16 * st + 4 * fq + j;
            const bool ok = dir ? (s >= lrow_v) : (s <= lrow_v);
            mv[j] = ok ? gt_[j] * fexp(fminf(cl - s_cum[s], 0.f)) : 0.f;
          }
          st_bf4(Ms + lrow_me * 136 + 16 * st + 4 * fq, mv);
        }
        __syncthreads();
        const float el = fexp(cl);
#pragma unroll
        for (int pt = 0; pt < 4; ++pt) {
          const f32x4 a1 = mma_lds(Vt + pt * 16 * 136, 136, Ms + wid * 16 * 136, 136, 128, zero4, fr, fq);
          const f32x4 a2 = mma_lds(St + pt * 16 * 72, 72, A0 + wid * 16 * 72, 72, 64, zero4, fr, fq);
          yacc[pt] += a1 + el * a2;
        }
      }
      const int pp = c * 128 + lrow_me;
      if (pp >= PAD0) {
        const float dsk = p->ssd_d[l * 8 + hh];
        const size_t r = (size_t)r0 + lrow_me;
#pragma unroll
        for (int pt = 0; pt < 4; ++pt) {
          const f32x4 xs = ld_bf4(xc + r * 768 + hh * 64 + pt * 16 + 4 * fq);
          st_bf4(mixed + r * 2048 + 512 + hh * 64 + pt * 16 + 4 * fq, yacc[pt] + dsk * xs);
        }
      }
    }
  }
  for (int i2 = (blockIdx.x + 32) % gridDim.x; i2 < NMI; i2 += gridDim.x) {
    __syncthreads();
    {
      const int hm = i2 & 3, bc = i2 >> 2, c = bc % NCH, b = bc / NCH;
      const int r0 = b * TP + c * 128;
#pragma unroll
      for (int i = 0; i < 2; ++i) {
        const int id = tid + 512 * i, lrow = id >> 3, c8 = id & 7;
        float qv[8]; ld_bf8(mqk + (size_t)(r0 + lrow) * 1536 + hm * 64 + c8 * 8, qv);
#pragma unroll
        for (int e = 0; e < 8; ++e) qv[e] *= 0.125f;
        st_bf8(A0 + lrow * 72 + c8 * 8, qv);
        *(uint4*)(A1 + lrow * 72 + c8 * 8) = *(const uint4*)(mqk + (size_t)(r0 + lrow) * 1536 + 256 + hm * 64 + c8 * 8);
      }
#pragma unroll
      for (int i = 0; i < 4; ++i) {
        const int id = tid + 512 * i, lrow = id >> 4, c8 = id & 15;
        const uint4 vw = *(const uint4*)(mqk + (size_t)(r0 + lrow) * 1536 + 512 + hm * 128 + c8 * 8);
        const bf16x8 vv = __builtin_bit_cast(bf16x8, vw);
#pragma unroll
        for (int e = 0; e < 8; ++e) Vt[(c8 * 8 + e) * 136 + lrow] = (bf16_t)vv[e];
      }
      for (int id = tid; id < 16 * 128; id += 512) { const int vr = id >> 7, lrow = id & 127; Vt[(128 + vr) * 136 + lrow] = vr == 0 ? (bf16_t)0x3f80 : (bf16_t)0; }
      __syncthreads();
      f32x4 hacc[8];
#pragma unroll
      for (int vt = 0; vt < 8; ++vt) hacc[vt] = zero4;
      const int lrow_me = 16 * wid + fr;
      for (int dir = 0; dir < 2; ++dir) {
        __syncthreads();
        if (tid < 128) { s_a[tid] = gates[(size_t)(r0 + tid) * 32 + 24 + dir * 4 + hm]; s_b[tid] = gates[(size_t)(r0 + tid) * 32 + 16 + dir * 4 + hm]; }
        __syncthreads();
        if (wid == 0) scan128_sum(s_a, s_cum, dir, lane);
        __syncthreads();
        if (tid < 128) s_a[tid] = s_b[tid] - s_cum[tid];
        __syncthreads();
        if (wid == 0) scan128_max(s_a, s_pm, dir, lane);
        const int cp = dir ? NCH - 1 - c : c;
        const size_t sidx = (size_t)((b * 4 + hm) * 2 + dir) * NCH + cp;
        for (int id = tid; id < 2304; id += 512) {
          const f32x4 v = *(const f32x4*)(mls + sidx * 9216 + id * 4);
          st_bf4(St + (id >> 4) * 72 + (id & 15) * 4, v);
        }
        const float mst = mlg[sidx * 3 + 2];
        __syncthreads();
        const float cl = s_cum[lrow_me];
        int lrow_v = lrow_me; asm volatile("" : "+v"(lrow_v));
        const float mrow = cl + fmaxf(s_pm[lrow_me], mst);
        const float winter = fexp(fminf(cl + mst - mrow, 0.f));
#pragma unroll 1
        for (int st = 0; st < 8; ++st) {
          f32x4 mv;
          const f32x4 s0_ = mma_lds(A1 + st * 16 * 72, 72, A0 + wid * 16 * 72, 72, 64, zero4, fr, fq);
#pragma unroll
          for (int j = 0; j < 4; ++j) {
            const int s = 16 * st + 4 * fq + j;
            const bool ok = dir ? (s >= lrow_v) : (s <= lrow_v);
            mv[j] = ok ? s0_[j] * fexp(fminf(cl + s_a[s] - mrow, 0.f)) : 0.f;
          }
          st_bf4(Ms + lrow_me * 136 + 16 * st + 4 * fq, mv);
        }
        __syncthreads();
        float dd;
        {
          const f32x4 a1 = mma_lds(Vt + 8 * 16 * 136, 136, Ms + wid * 16 * 136, 136, 128, zero4, fr, fq);
          const f32x4 a2 = mma_lds(St + 8 * 16 * 72, 72, A0 + wid * 16 * 72, 72, 64, zero4, fr, fq);
          const float den = __shfl(a1[0] + winter * a2[0], fr);
          dd = 1.f / fmaxf(fabsf(den), fexp(-mrow));
        }
#pragma unroll
        for (int vt = 0; vt < 8; ++vt) {
          const f32x4 a1 = mma_lds(Vt + vt * 16 * 136, 136, Ms + wid * 16 * 136, 136, 128, zero4, fr, fq);
          const f32x4 a2 = mma_lds(St + vt * 16 * 72, 72, A0 + wid * 16 * 72, 72, 64, zero4, fr, fq);
          hacc[vt] += (a1 + winter * a2) * dd;
        }
      }
      const int pp = c * 128 + lrow_me;
      if (pp >= PAD0) {
        const size_t r = (size_t)r0 + lrow_me;
#pragma unroll
        for (int vt = 0; vt < 8; ++vt) st_bf4(mixed + r * 2048 + 1536 + hm * 128 + vt * 16 + 4 * fq, hacc[vt]);
      }
    }
  }
  __syncthreads();
}


#ifndef DBGCHK
#define DBGCHK 0
#endif
#if DBGCHK
DI float blk_max(float v, float* red, int tid) {
  v = wmax(v); __syncthreads(); if ((tid & 63) == 0) red[tid >> 6] = v; __syncthreads();
  float r = red[0]; for (int i = 1; i < 8; ++i) r = fmaxf(r, red[i]); return r;
}
DI float blk_sum(float v, float* red, int tid) {
  v = wsum(v); __syncthreads(); if ((tid & 63) == 0) red[tid >> 6] = v; __syncthreads();
  float r = 0.f; for (int i = 0; i < 8; ++i) r += red[i]; return r;
}
DI void dbg_check_attn(PmK p, char* lds) {
  LAUNDER(p);
  const int tid = otid();
  float* w = (float*)lds; float* red = w + 8320;
  const int b = 1, j = 2, h = 1, pq = 5000;
  const bf16_t* base = (const bf16_t*)(p->ws + OFF_DQKV) + (size_t)b * TP * 1536;
  const bf16_t* mixed = (const bf16_t*)(p->ws + OFF_MIXED);
  float mx = NEGF;
  for (int t = PAD0 + tid; t < TP; t += 512) {
    float s = 0.f;
    for (int c = 0; c < 64; ++c) s += bf2f(base[(size_t)pq * 1536 + j * 64 + c]) * bf2f(base[(size_t)t * 1536 + 512 + j * 64 + c]);
    w[t] = s; mx = fmaxf(mx, s);
  }
  const float M = blk_max(mx, red, tid);
  float ls = 0.f;
  for (int t = PAD0 + tid; t < TP; t += 512) { const float e = __builtin_amdgcn_exp2f(w[t] - M); w[t] = e; ls += e; }
  const float L = blk_sum(ls, red, tid);
  __syncthreads();
  float err = 0.f, mag = 0.f;
  if (tid < 128) {
    float o = 0.f;
    for (int t = PAD0; t < TP; ++t) o += w[t] * bf2f(base[(size_t)t * 1536 + 1024 + h * 128 + tid]);
    o /= L;
    const float kv = bf2f(mixed[((size_t)b * TP + pq) * 2048 + 1024 + h * 128 + tid]);
    err = fabsf(o - kv); mag = fabsf(o);
  }
  const float E = blk_max(err, red, tid), G = blk_max(mag, red, tid);
  if (tid == 0) ((float*)(p->ws + OFF_SCAL))[8] = 1000.f + 1000.f * fminf(E / G, 50.f);
}

DI void dbg_check_p2x(PmK p, int l, char* lds) {
  LAUNDER(p);
  const int tid = otid();
  float* raw = (float*)lds; float* red = raw + 256;
  const int b = 1, pq = 5000, r = b * TP + pq;
  const bf16_t* hn = (const bf16_t*)(p->ws + OFF_HN); const bf16_t* win = (const bf16_t*)(p->ws + OFF_WIN);
  const bf16_t* dqkv = (const bf16_t*)(p->ws + OFF_DQKV);
  float err = 0.f, mag = 0.f;
  for (int hsel = 0; hsel < 2; ++hsel) {
    const int hd = hsel ? 19 : 17;
    __syncthreads();
    if (tid < 64) { float a = 0.f; for (int k = 0; k < 1024; ++k) a += bf2f(hn[(size_t)r * 1024 + k]) * bf2f(win[(size_t)(672 + hd * 64 + tid) * 1024 + k]); raw[tid] = a; }
    __syncthreads();
    if (tid < 64) {
      float ss = 0.f; for (int c = 0; c < 64; ++c) ss += raw[c] * raw[c];
      const float rinv = rsqrtf(ss / 64.f + 1e-6f) * (hd < 8 ? 0.125f * LOG2E : 1.f);
      const float* g = (hd < 8 ? p->dq_g : p->dk_g) + l * 64; if (hd >= 16) g = p->dq_g;
      auto nv = [&](int c) { return raw[c] * rinv * g[c]; };
      float o = nv(tid);
      if (tid < 16) { const int i = tid & 7; float cs, sn; sincos_rev((float)(pq - PAD0) * p->inv_d[i], cs, sn);
        o = tid < 8 ? nv(tid) * cs - nv(tid + 8) * sn : nv(tid) * cs + nv(tid - 8) * sn; }
      const float kv = bf2f(dqkv[(size_t)r * 1536 + hd * 64 + tid]);
      if (hd >= 16) o = raw[tid];
      err = fmaxf(err, fabsf(o - kv)); mag = fmaxf(mag, fabsf(o));
    }
  }
  const float E = blk_max(err, red, tid), G = blk_max(mag, red, tid);
  if (tid == 0) ((float*)(p->ws + OFF_SCAL))[8] = 1000.f + 1000.f * fminf(E / G, 50.f);
}
#endif
#define EPI_WRAP(name, f) auto name = [=](const f32x4 (&acc)[2][2][4][2], int pm, int pn, int wr, int wc, int fr, int fq) { epi_each(acc, pm, pn, wr, wc, fr, fq, f); }
__global__ void __launch_bounds__(512) mega(Pm p_unused) {
  PmK p = (PmK)__builtin_amdgcn_kernarg_segment_ptr();
  extern __shared__ __attribute__((aligned(16))) char lds[];
  cg::grid_group grid = cg::this_grid();
  const int lo = p->ph0, hi = p->ph1;
#define IN(k) ((ONLY < 0 || ONLY == (k)) && lo <= l * NPH + (k) && l * NPH + (k) < hi)
#define SEAM(k) do { if (l * NPH + (k) + 1 < hi) grid.sync(); } while (0)
  for (int l = 0; l < 2; ++l) {
    if (IN(0)) { LAUNDER(p); char* const ws = p->ws; (void)ws; phase_prep(p, l, lds); SEAM(0); }
    if (IN(1)) { LAUNDER(p); char* const ws = p->ws; (void)ws;
      bf16_t* pa = (bf16_t*)(ws + OFF_PA); bf16_t* dqkv = (bf16_t*)(ws + OFF_DQKV);
      auto f = [=](int row, int col, f32x4 v) {
        if (col < 672) st_bf4(pa + (size_t)row * 672 + col, v);
        else if (col < 2208) st_bf4(dqkv + (size_t)row * 1536 + (col - 672), v);
      };
      EPI_WRAP(epi, f);
      gemm_simple(lds, (const bf16_t*)(ws + OFF_HN), 1024, (const bf16_t*)(ws + OFF_WIN), 1024, R / 256, XW / 256, 1024, epi);
      SEAM(1);
    }
    if (IN(2)) { LAUNDER(p); char* const ws = p->ws; (void)ws;
      bf16_t* mq = (bf16_t*)(ws + OFF_MQ); bf16_t* knr = (bf16_t*)(ws + OFF_KNR); bf16_t* mv = (bf16_t*)(ws + OFF_MV);
      auto fq_ = [=](int row, int col, f32x4 v) { st_bf4(mq + (size_t)row * 768 + col, v); };
      EPI_WRAP(epiq, fq_);
      gemm_simple(lds, (const bf16_t*)(ws + OFF_PA), 672, (const bf16_t*)(ws + OFF_WUQ), 384, R / 256, 3, 384, epiq);
      auto fkv = [=](int row, int col, f32x4 v) {
        const int hh = col >> 7, c = col & 127;
        if (c < 64) st_bf4(knr + (size_t)row * 512 + hh * 64 + c, v); else st_bf4(mv + (size_t)row * 512 + hh * 64 + (c - 64), v);
      };
      EPI_WRAP(epikv, fkv);
      gemm_simple(lds, (const bf16_t*)(ws + OFF_PA) + 384, 672, (const bf16_t*)(ws + OFF_WUKV), 256, R / 256, 4, 256, epikv);
      SEAM(2);
    }
    if (IN(3)) { LAUNDER(p); char* const ws = p->ws; (void)ws; phase_p3(p, l, lds); phase_p2x(p, l); SEAM(3); }
    if (IN(4)) { LAUNDER(p); char* const ws = p->ws; (void)ws; phase_attn(p, lds); SEAM(4); }
    if (IN(5)) { LAUNDER(p); char* const ws = p->ws; (void)ws;
      bf16_t* sz = (bf16_t*)(ws + OFF_SZ); bf16_t* xr = (bf16_t*)(ws + OFF_XBCR); bf16_t* mo = (bf16_t*)(ws + OFF_MQKVO); float* gates = (float*)(ws + OFF_GATES);
      auto f = [=](int row, int col, f32x4 v) {
        if (col < 512) st_bf4(sz + (size_t)row * 512 + col, v);
        else if (col < 1280) st_bf4(xr + (size_t)row * 768 + (col - 512), v);
        else if (col < 2816) st_bf4(mo + (size_t)row * 1536 + (col - 1280), v);
        else if (col < 2848) *(f32x4*)(gates + (size_t)row * 32 + (col - 2816)) = v;
      };
      EPI_WRAP(epi, f);
      gemm_simple(lds, (const bf16_t*)(ws + OFF_HN), 1024, (const bf16_t*)(ws + OFF_WIN) + (size_t)XW * 1024, 1024, R / 256, YW / 256, 1024, epi);
      SEAM(5);
    }
    if (IN(6)) { LAUNDER(p); char* const ws = p->ws; (void)ws; phase_p2y(p, l); SEAM(6); }
    if (IN(7)) { LAUNDER(p); char* const ws = p->ws; (void)ws; phase_states(p, l, lds); SEAM(7); }
    if (IN(8)) { LAUNDER(p); char* const ws = p->ws; (void)ws; phase_scan(p); SEAM(8); }
    if (IN(9)) { LAUNDER(p); char* const ws = p->ws; (void)ws; phase_out(p, l, lds); SEAM(9); }
    if (IN(10)) { LAUNDER(p); char* const ws = p->ws; (void)ws; phase_post(p, l); SEAM(10); }
    if (IN(11)) { LAUNDER(p); char* const ws = p->ws; (void)ws;
      float* const outp = p->out; float* const metah = (float*)(ws + OFF_METAH);
      auto f = [=](int row, int col, f32x4 v) { float* hr = hrow2(outp, metah, row); if (hr) { f32x4* d = (f32x4*)(hr + col); *d = *d + v; } };
      EPI_WRAP(epi, f);
      gemm_simple(lds, (const bf16_t*)(ws + OFF_MIXED), 2048, (const bf16_t*)(ws + OFF_WOUT), 2048, R / 256, 4, 2048, epi);
      SEAM(11);
    }
    if (IN(12)) { LAUNDER(p); char* const ws = p->ws; (void)ws; norm_rows(p, false); SEAM(12); }
    if (IN(13)) { LAUNDER(p); char* const ws = p->ws; (void)ws;
      bf16_t* act = (bf16_t*)(ws + OFF_ACT);
      auto epi = [=](const f32x4 (&acc)[2][2][4][2], int pm, int pn, int wr, int wc, int fr, int fq) {
#pragma unroll
        for (int ai = 0; ai < 2; ++ai)
#pragma unroll
          for (int m = 0; m < 4; ++m) {
            const int row = pm * 256 + 128 * ai + 64 * wr + 16 * m + fr;
#pragma unroll
            for (int n = 0; n < 2; ++n) {
              const f32x4 g = acc[ai][0][m][n], u = acc[ai][1][m][n];
              f32x4 a; a[0] = siluf(g[0]) * u[0]; a[1] = siluf(g[1]) * u[1]; a[2] = siluf(g[2]) * u[2]; a[3] = siluf(g[3]) * u[3];
              st_bf4(act + (size_t)row * 2816 + pn * 128 + 32 * wc + 16 * n + 4 * fq, a);
            }
          }
      };
      gemm_simple(lds, (const bf16_t*)(ws + OFF_HN), 1024, (const bf16_t*)(ws + OFF_WFI), 1024, R / 256, 22, 1024, epi);
      SEAM(13);
    }
    if (IN(14)) { LAUNDER(p); char* const ws = p->ws; (void)ws;
      float* const outp = p->out; float* const metah = (float*)(ws + OFF_METAH);
      auto f = [=](int row, int col, f32x4 v) { float* hr = hrow2(outp, metah, row); if (hr) { f32x4* d = (f32x4*)(hr + col); *d = *d + v; } };
      EPI_WRAP(epi, f);
      gemm_simple(lds, (const bf16_t*)(ws + OFF_ACT), 2816, (const bf16_t*)(ws + OFF_WFO), 2816, R / 256, 4, 2816, epi);
      SEAM(14);
    }
  }
#undef IN
#undef SEAM
#if DBGCHK
  grid.sync();
  if (blockIdx.x == 0) dbg_check_p2x(p, 0, lds);
  grid.sync();
  { float* o = p->out; const float code = ((const float*)(p->ws + OFF_SCAL))[8];
    for (size_t i = (size_t)blockIdx.x * 512 + threadIdx.x; i < (size_t)4 * 8192 * 1024; i += (size_t)gridDim.x * 512) o[i] = i == 0 ? code : 0.f; }
#endif
}

__global__ void __launch_bounds__(512) dbg_hash(const unsigned* ws, size_t nwords, float* out) {
  const size_t gt = (size_t)blockIdx.x * 512 + threadIdx.x, gn = (size_t)gridDim.x * 512;
  unsigned h = 0;
  for (size_t i = gt; i < nwords; i += gn) h = h * 31u + ws[i];
  out[gt] = (float)(h & 0xFFFFFu);
}
constexpr size_t LDS_BYTES = 140 * 1024;
extern "C" void kernel_launch(void* const* d_in, const int* in_sizes, int n_in, void* d_out, int out_size, void* d_ws, size_t ws_size, hipStream_t stream) {
  static int grid_blocks = 0;
  if (!grid_blocks) {
    if (ws_size < WS_NEED) { fprintf(stderr, "kernel_launch: workspace too small: %zu < %zu\n", ws_size, WS_NEED); return; }
    if (hipFuncSetAttribute((const void*)mega, hipFuncAttributeMaxDynamicSharedMemorySize, (int)LDS_BYTES) != hipSuccess) { fprintf(stderr, "kernel_launch: LDS attribute failed\n"); return; }
    int dev = 0, cus = 0, per_cu = 0;
    hipGetDevice(&dev);
    hipDeviceGetAttribute(&cus, hipDeviceAttributeMultiprocessorCount, dev);
    hipOccupancyMaxActiveBlocksPerMultiprocessor(&per_cu, mega, 512, LDS_BYTES);
    if (per_cu < 1) { fprintf(stderr, "kernel_launch: occupancy 0\n"); return; }
    grid_blocks = cus * 1;
  }
  Pm p;
  memset(&p, 0, sizeof(p));
  const float** fp = (const float**)&p;
  for (int i = 0; i < 28; ++i) fp[i] = (const float*)d_in[i];
  p.out = (float*)d_out; p.ws = (char*)d_ws;
  for (int i = 0; i < 16; ++i) p.inv_m[i] = 1.0f / powf(500000.0f, (float)(2 * i) / 32.0f);
  for (int i = 0; i < 8; ++i) p.inv_d[i] = 1.0f / powf(500000.0f, (float)(2 * i) / 16.0f);
  for (int l = 0; l < 2; ++l) p.linit[l] = (float)(0.8 - 0.6 * exp(-0.3 * l));
#if MULTI
  for (int ph = 0; ph < DBG_NPH; ++ph) {
    p.ph0 = ph; p.ph1 = ph + 1;
    hipLaunchKernelGGL(mega, dim3(grid_blocks), dim3(512), LDS_BYTES, stream, p);
  }
#else
  p.ph0 = 0; p.ph1 = DBGCHK ? 5 : 2 * NPH;
  void* args[] = {&p};
  hipError_t e = hipLaunchCooperativeKernel((void*)mega, dim3(grid_blocks), dim3(512), args, LDS_BYTES, stream);
  if (e != hipSuccess) fprintf(stderr, "cooperative launch failed: %s (grid %d)\n", hipGetErrorString(e), grid_blocks);
#endif
}
```

```cpp
#include <hip/hip_runtime.h>
#include <hip/hip_cooperative_groups.h>
#include <cstdio>
#include <cmath>
#include <cstring>
namespace cg = cooperative_groups;

typedef unsigned short bf16_t;
typedef short bf16x8 __attribute__((ext_vector_type(8)));
typedef float f32x4 __attribute__((ext_vector_type(4)));
typedef unsigned u32x4 __attribute__((ext_vector_type(4)));
#define DI __device__ __forceinline__
#define MFMA16(a, b, c) __builtin_amdgcn_mfma_f32_16x16x32_bf16((a), (b), (c), 0, 0, 0)

#ifndef MULTI
#define MULTI 0
#endif
#ifndef DBG_NPH
#define DBG_NPH (2 * NPH)
#endif
#ifndef ZB
#define ZB -1
#endif
#ifndef DUP
#define DUP 0
#endif
#ifndef ONLY
#define ONLY -1
#endif

constexpr int NB = 4, TP = 8320, R = NB * TP, NCH = 65, PAD0 = 112;
constexpr int XW = 2304, YW = 3072;
constexpr int NPH = 15;
constexpr float NEGF = -1e30f;
constexpr float LOG2E = 1.4426950408889634f;

constexpr size_t al256(size_t x) { return (x + 255) & ~size_t(255); }
constexpr size_t SZ_WIN = (size_t)(XW + YW) * 1024 * 2, SZ_WUQ = (size_t)768 * 384 * 2, SZ_WUKV = (size_t)1024 * 256 * 2,
                 SZ_WOUT = (size_t)1024 * 2048 * 2, SZ_WFI = (size_t)5632 * 1024 * 2, SZ_WFO = (size_t)1024 * 2816 * 2;
constexpr size_t OFF_WIN = 0, OFF_WUQ = OFF_WIN + al256(SZ_WIN), OFF_WUKV = OFF_WUQ + al256(SZ_WUQ), OFF_WOUT = OFF_WUKV + al256(SZ_WUKV),
                 OFF_WFI = OFF_WOUT + al256(SZ_WOUT), OFF_WFO = OFF_WFI + al256(SZ_WFI), OFF_METAH = OFF_WFO + al256(SZ_WFO),
                 OFF_SCAL = OFF_METAH + al256((size_t)64 * 1024 * 4), OFF_SSDD = OFF_SCAL + 256,
                 OFF_MLG = OFF_SSDD + al256((size_t)64 * NCH * 4), OFF_HN = OFF_MLG + al256((size_t)32 * NCH * 3 * 4);
constexpr size_t SZ_HN = (size_t)R * 1024 * 2;
constexpr size_t OFF_SSDS = OFF_HN;
constexpr size_t OFF_MIXED = OFF_HN + al256(SZ_HN);
constexpr size_t SZ_MIXED = (size_t)R * 2048 * 2;
constexpr size_t OFF_PA = OFF_MIXED, OFF_KNR = OFF_PA + al256((size_t)R * 672 * 2), OFF_MVR = OFF_KNR + al256((size_t)R * 512 * 2);
constexpr size_t OFF_U = OFF_MIXED + al256(SZ_MIXED);
constexpr size_t OFF_DQKV = OFF_U, OFF_MQ = OFF_DQKV + al256((size_t)R * 1536 * 2), OFF_MK = OFF_MQ + al256((size_t)R * 768 * 2),
                 OFF_MVT = OFF_MK + al256((size_t)R * 768 * 2), OFF_DVT = OFF_MVT + al256((size_t)R * 512 * 2), END_X = OFF_DVT + al256((size_t)R * 512 * 2);
constexpr size_t OFF_SZ = OFF_U, OFF_XBCC = OFF_SZ + al256((size_t)R * 512 * 2), OFF_MQKVO = OFF_XBCC + al256((size_t)R * 768 * 2),
                 OFF_GATES = OFF_MQKVO + al256((size_t)R * 1536 * 2), OFF_MLS = OFF_GATES + al256((size_t)R * 32 * 4),
                 END_Y = OFF_MLS + al256((size_t)32 * NCH * 9216 * 4);
constexpr size_t OFF_XBCR = OFF_MLS;
constexpr size_t OFF_ACT = OFF_U, END_F = OFF_ACT + al256((size_t)R * 2816 * 2);
constexpr size_t WS_NEED = (END_X > END_Y ? (END_X > END_F ? END_X : END_F) : (END_Y > END_F ? END_Y : END_F));
static_assert(SZ_HN == (size_t)64 * NCH * 4096 * 4, "ssd states alias hn");
static_assert(OFF_MVR + (size_t)R * 512 * 2 <= OFF_U, "transients fit in mixed");
static_assert((size_t)R * 768 * 2 <= (size_t)32 * NCH * 9216 * 4, "xbc raw fits in mlstm states");

struct Pm {
  const float *x, *meta, *attn_g, *w_in, *q_norm_g, *kv_norm_g, *w_uq, *w_ukv, *q_head_g, *k_head_g, *mla_out_g, *conv_w, *conv_b,
      *dt_bias, *a_log, *ssd_d, *ssd_norm_g, *dq_g, *dk_g, *dlam, *dout_g, *i_bias, *f_bias, *ml_out_g, *w_out, *ffn_g, *w_fi, *w_fo;
  float* out;
  char* ws;
  float inv_m[16];
  float inv_d[8];
  float linit[2];
  int ph0, ph1;
};

typedef const Pm __attribute__((address_space(4)))* PmK;
#define LAUNDER(p) asm volatile("" : "+s"(p))
DI int otid() { int t = threadIdx.x; asm volatile("" : "+v"(t)); return t; }
typedef __bf16 bf2_t __attribute__((ext_vector_type(2)));
typedef float f32x2 __attribute__((ext_vector_type(2)));
DI unsigned cvt_pk(float lo, float hi) { f32x2 v = {lo, hi}; bf2_t b = __builtin_convertvector(v, bf2_t); return __builtin_bit_cast(unsigned, b); }
DI bf16_t f2bf(float x) { return (bf16_t)(cvt_pk(x, 0.f) & 0xffffu); }
DI float bf2f(bf16_t b) { return __uint_as_float(((unsigned)b) << 16); }
DI float bflo(unsigned w) { return __uint_as_float(w << 16); }
DI float bfhi(unsigned w) { return __uint_as_float(w & 0xffff0000u); }
DI void st_bf4(bf16_t* dst, f32x4 v) { uint2 w; w.x = cvt_pk(v[0], v[1]); w.y = cvt_pk(v[2], v[3]); *(uint2*)dst = w; }
DI f32x4 ld_bf4(const bf16_t* src) { uint2 w = *(const uint2*)src; f32x4 v; v[0] = bflo(w.x); v[1] = bfhi(w.x); v[2] = bflo(w.y); v[3] = bfhi(w.y); return v; }
DI void ld_bf8(const bf16_t* src, float* v) { uint4 w = *(const uint4*)src; v[0] = bflo(w.x); v[1] = bfhi(w.x); v[2] = bflo(w.y); v[3] = bfhi(w.y); v[4] = bflo(w.z); v[5] = bfhi(w.z); v[6] = bflo(w.w); v[7] = bfhi(w.w); }
DI void st_bf8(bf16_t* dst, const float* v) { uint4 w; w.x = cvt_pk(v[0], v[1]); w.y = cvt_pk(v[2], v[3]); w.z = cvt_pk(v[4], v[5]); w.w = cvt_pk(v[6], v[7]); *(uint4*)dst = w; }
DI float wsum(float v) { for (int m = 32; m >= 1; m >>= 1) v += __shfl_xor(v, m); return v; }
DI float wmax(float v) { for (int m = 32; m >= 1; m >>= 1) v = fmaxf(v, __shfl_xor(v, m)); return v; }
DI float fexp(float x) { return __builtin_amdgcn_exp2f(x * LOG2E); }
DI float siluf(float x) { return x / (1.f + fexp(-x)); }
DI float sigmf(float x) { return 1.f / (1.f + fexp(-x)); }
DI float softplusf(float x) { return x > 20.f ? x : log1pf(__expf(x)); }
DI float* hrow2(float* out, float* metah, int r) {
  const int b = r / TP, pp = r - b * TP;
  if (pp < PAD0) return nullptr;
  if (pp < 128) return metah + (size_t)(b * 16 + pp - PAD0) * 1024;
  return out + ((size_t)b * 8192 + pp - 128) * 1024;
}
DI float* hrow(PmK p, int r) { return hrow2(p->out, (float*)(p->ws + OFF_METAH), r); }
DI void sincos_rev(float ang, float& c, float& s) {
  double rev = (double)ang * 0.15915494309189535; rev -= rint(rev); const float f = (float)rev;
  s = __builtin_amdgcn_sinf(f); c = __builtin_amdgcn_cosf(f);
}
DI f32x4 mma_lds(const bf16_t* X, int ldx, const bf16_t* Y, int ldy, int K, f32x4 acc, int fr, int fq) {
  for (int k0 = 0; k0 < K; k0 += 32) {
    const bf16x8 x = *(const bf16x8*)(X + fr * ldx + k0 + fq * 8), y = *(const bf16x8*)(Y + fr * ldy + k0 + fq * 8);
    acc = MFMA16(x, y, acc);
  }
  __builtin_amdgcn_sched_barrier(0);
  return acc;
}
DI void scan128_sum(const float* v, float* cum, int dir, int lane) {
  const int i0 = 2 * lane, n0 = dir ? 127 - i0 : i0, n1 = dir ? 126 - i0 : i0 + 1;
  const float a = v[n0], b = a + v[n1]; float s = b;
  for (int d = 1; d < 64; d <<= 1) { const float t = __shfl_up(s, d); if (lane >= d) s += t; }
  const float ex = s - b; cum[n0] = ex + a; cum[n1] = ex + b;
}
DI void scan128_max(const float* v, float* cum, int dir, int lane) {
  const int i0 = 2 * lane, n0 = dir ? 127 - i0 : i0, n1 = dir ? 126 - i0 : i0 + 1;
  const float a = v[n0], b = fmaxf(a, v[n1]); float s = b;
  for (int d = 1; d < 64; d <<= 1) { const float t = __shfl_up(s, d); if (lane >= d) s = fmaxf(s, t); }
  float ex = __shfl_up(s, 1); if (lane == 0) ex = NEGF * 3.f;
  cum[n0] = fmaxf(ex, a); cum[n1] = fmaxf(ex, b);
}

DI int map_in(int n) {
  if (n < 672) return n;
  if (n < 1184) return XW + (n - 672);
  if (n < 1952) return XW + 512 + (n - 1184);
  if (n < 1968) return XW + 2816 + (n - 1952);
  if (n < 3504) return 672 + (n - 1968);
  if (n < 5040) return XW + 1280 + (n - 3504);
  return XW + 2832 + (n - 5040);
}
DI int map_fi(int n) { const int half = n >= 2816, j = n - half * 2816; return 256 * (j >> 7) + half * 128 + (j & 127); }
template <int MODE>
DI void wtrans(char* lds, const float* __restrict__ W, int K, int N, const float* __restrict__ g, bf16_t* __restrict__ Wt) {
  float* tl = (float*)lds;
  const int tid = otid(), nkt = K / 64, nnt = N / 64;
  for (int t = blockIdx.x; t < nkt * nnt; t += gridDim.x) {
    const int kt = t % nkt, nt = t / nkt;
    __syncthreads();
#pragma unroll
    for (int i = 0; i < 8; ++i) {
      const int k = (tid >> 6) + 8 * i, n = tid & 63;
      float v = W[(size_t)(kt * 64 + k) * N + nt * 64 + n];
      if (g) v *= g[kt * 64 + k];
      tl[k * 65 + n] = v;
    }
    __syncthreads();
#pragma unroll
    for (int i = 0; i < 8; ++i) {
      const int n = (tid >> 6) + 8 * i, k = tid & 63, gn = nt * 64 + n;
      const int dst = MODE == 1 ? map_in(gn) : MODE == 2 ? map_fi(gn) : gn;
      Wt[(size_t)dst * K + kt * 64 + k] = f2bf(tl[k * 65 + n]);
    }
  }
}

DI void norm_rows(PmK p, bool first) {
  LAUNDER(p);
  const int tid_ = otid(), wid = tid_ >> 6, lane = tid_ & 63;
  bf16_t* hn = (bf16_t*)(p->ws + OFF_HN);
  for (int r = blockIdx.x * 8 + wid; r < R; r += gridDim.x * 8) {
    const int b = r / TP, pp = r - b * TP;
    bf16_t* dst = hn + (size_t)r * 1024;
    if (pp < PAD0) {
      const uint4 z = {0u, 0u, 0u, 0u};
      *(uint4*)(dst + lane * 16) = z; *(uint4*)(dst + lane * 16 + 8) = z;
      continue;
    }
    float* hr = hrow(p, r);
    const float* src = first ? (pp < 128 ? p->meta + (size_t)(pp - PAD0) * 1024 : p->x + ((size_t)b * 8192 + pp - 128) * 1024) : hr;
    f32x4 v[4]; float ss = 0.f;
#pragma unroll
    for (int i = 0; i < 4; ++i) { v[i] = *(const f32x4*)(src + i * 256 + lane * 4); ss += v[i][0] * v[i][0] + v[i][1] * v[i][1] + v[i][2] * v[i][2] + v[i][3] * v[i][3]; }
    ss = wsum(ss);
    const float rinv = rsqrtf(ss * (1.f / 1024.f) + 1e-6f);
#pragma unroll
    for (int i = 0; i < 4; ++i) {
      if (first) *(f32x4*)(hr + i * 256 + lane * 4) = v[i];
      st_bf4(dst + i * 256 + lane * 4, v[i] * rinv);
    }
  }
}

DI void phase_prep(PmK p, int l, char* lds) {
  LAUNDER(p);
  char* ws = p->ws;
  wtrans<1>(lds, p->w_in + (size_t)l * 1024 * 5056, 1024, 5056, p->attn_g + l * 1024, (bf16_t*)(ws + OFF_WIN));
  wtrans<0>(lds, p->w_uq + (size_t)l * 384 * 768, 384, 768, p->q_norm_g + l * 384, (bf16_t*)(ws + OFF_WUQ));
  wtrans<0>(lds, p->w_ukv + (size_t)l * 256 * 1024, 256, 1024, p->kv_norm_g + l * 256, (bf16_t*)(ws + OFF_WUKV));
  wtrans<0>(lds, p->w_out + (size_t)l * 2048 * 1024, 2048, 1024, nullptr, (bf16_t*)(ws + OFF_WOUT));
  wtrans<2>(lds, p->w_fi + (size_t)l * 1024 * 5632, 1024, 5632, p->ffn_g + l * 1024, (bf16_t*)(ws + OFF_WFI));
  wtrans<0>(lds, p->w_fo + (size_t)l * 2816 * 1024, 2816, 1024, nullptr, (bf16_t*)(ws + OFF_WFO));
  bf16_t* win = (bf16_t*)(ws + OFF_WIN);
  for (int i = blockIdx.x * 512 + threadIdx.x; i < (96 + 224) * 1024; i += gridDim.x * 512) {
    const int row = i >> 10, k = i & 1023;
    const int dst = row < 96 ? 2208 + row : XW + 2848 + (row - 96);
    win[(size_t)dst * 1024 + k] = 0;
  }
  if (blockIdx.x == 0 && threadIdx.x < 64) {
    const float* lam = p->dlam + l * 256; const int t = threadIdx.x;
    const float s1 = wsum(lam[t] * lam[64 + t]), s2 = wsum(lam[128 + t] * lam[192 + t]);
    if (t == 0) { ((float*)(ws + OFF_SCAL))[0] = expf(s1) - expf(s2) + p->linit[l]; ((int*)(ws + OFF_SCAL))[16] = 0; }
  }
  norm_rows(p, l == 0);
}

template <class Epi>
DI void gemm_simple(char* lds, const bf16_t* __restrict__ A, int lda, const bf16_t* __restrict__ Bt, int ldb, int nM, int nN, int K, const Epi& epi) {
  const int tid = otid(), wid = tid >> 6, lane = tid & 63, wr = wid >> 2, wc = wid & 3, fr = lane & 15, fq = lane >> 4;
  bf16_t* As = (bf16_t*)lds; bf16_t* Bs = As + 256 * 72;
  for (int tile = blockIdx.x; tile < nM * nN; tile += gridDim.x) {
    const int pm = tile / nN, pn = tile - pm * nN;
    f32x4 acc[2][2][4][2];
#pragma unroll
    for (int a = 0; a < 2; ++a)
#pragma unroll
      for (int b = 0; b < 2; ++b)
#pragma unroll
        for (int m = 0; m < 4; ++m)
#pragma unroll
          for (int n = 0; n < 2; ++n) acc[a][b][m][n] = (f32x4){0.f, 0.f, 0.f, 0.f};
    const bf16_t* Ab = A + (size_t)pm * 256 * lda + (size_t)(tid >> 3) * lda + (tid & 7) * 8;
    const bf16_t* Bb = Bt + (size_t)pn * 256 * ldb + (size_t)(tid >> 3) * ldb + (tid & 7) * 8;
    bf16_t* const Asw = As + (tid >> 3) * 72 + (tid & 7) * 8; bf16_t* const Bsw = Bs + (tid >> 3) * 72 + (tid & 7) * 8;
    bf16x8 ra[4], rb[4];
#pragma unroll
    for (int i = 0; i < 4; ++i) { ra[i] = *(const bf16x8*)(Ab + (size_t)i * 64 * lda); rb[i] = *(const bf16x8*)(Bb + (size_t)i * 64 * ldb); }
#pragma unroll 1
    for (int k0 = 0; k0 < K; k0 += 64) {
      __syncthreads();
#pragma unroll
      for (int i = 0; i < 4; ++i) { *(bf16x8*)(Asw + i * 64 * 72) = ra[i]; *(bf16x8*)(Bsw + i * 64 * 72) = rb[i]; }
      __syncthreads();
      if (k0 + 64 < K) {
        Ab += 64; Bb += 64;
#pragma unroll
        for (int i = 0; i < 4; ++i) { ra[i] = *(const bf16x8*)(Ab + (size_t)i * 64 * lda); rb[i] = *(const bf16x8*)(Bb + (size_t)i * 64 * ldb); }
      }
#pragma unroll
      for (int ks = 0; ks < 2; ++ks) {
        bf16x8 bfr[2][2];
#pragma unroll
        for (int bj = 0; bj < 2; ++bj)
#pragma unroll
          for (int n = 0; n < 2; ++n) bfr[bj][n] = *(const bf16x8*)(Bs + (128 * bj + 32 * wc + 16 * n + fr) * 72 + ks * 32 + fq * 8);
#pragma unroll
        for (int ai = 0; ai < 2; ++ai) {
          bf16x8 af[4];
#pragma unroll
          for (int m = 0; m < 4; ++m) af[m] = *(const bf16x8*)(As + (128 * ai + 64 * wr + 16 * m + fr) * 72 + ks * 32 + fq * 8);
#pragma unroll
          for (int bj = 0; bj < 2; ++bj)
#pragma unroll
            for (int m = 0; m < 4; ++m)
#pragma unroll
              for (int n = 0; n < 2; ++n) acc[ai][bj][m][n] = MFMA16(bfr[bj][n], af[m], acc[ai][bj][m][n]);
        }
      }
    }
    epi(acc, pm, pn, wr, wc, fr, fq);
  }
  __syncthreads();
}
template <class F>
DI void epi_each(const f32x4 (&acc)[2][2][4][2], int pm, int pn, int wr, int wc, int fr, int fq, const F& f) {
#pragma unroll
  for (int ai = 0; ai < 2; ++ai)
#pragma unroll
    for (int m = 0; m < 4; ++m) {
      const int row = pm * 256 + 128 * ai + 64 * wr + 16 * m + fr;
#pragma unroll
      for (int bj = 0; bj < 2; ++bj)
#pragma unroll
        for (int n = 0; n < 2; ++n) f(row, pn * 256 + 128 * bj + 32 * wc + 16 * n + 4 * fq, acc[ai][bj][m][n]);
    }
}

DI void phase_p2x(PmK p, int l) {
  LAUNDER(p);
  const int tid_ = otid(), wid = tid_ >> 6, lane = tid_ & 63;
  bf16_t* dqkv = (bf16_t*)(p->ws + OFF_DQKV);
  const int hd = lane >> 2, part = lane & 3;
  const float* g = (hd < 8 ? p->dq_g : p->dk_g) + l * 64 + part * 16;
  float gv[16];
#pragma unroll
  for (int e = 0; e < 16; ++e) gv[e] = g[e];
  const float qs = hd < 8 ? 0.125f * LOG2E : 1.f;
  for (int r = blockIdx.x * 8 + wid; r < R; r += gridDim.x * 8) {
    const int b = r / TP, pp = r - b * TP;
    bf16_t* ptr = dqkv + (size_t)r * 1536 + lane * 16;
    float v[16]; ld_bf8(ptr, v); ld_bf8(ptr + 8, v + 8);
    float ss = 0.f;
#pragma unroll
    for (int e = 0; e < 16; ++e) ss += v[e] * v[e];
    ss += __shfl_xor(ss, 1); ss += __shfl_xor(ss, 2);
    const float rinv = rsqrtf(ss * (1.f / 64.f) + 1e-6f) * qs;
#pragma unroll
    for (int e = 0; e < 16; ++e) v[e] *= rinv * gv[e];
    if (part == 0) {
      const float t = (float)(pp - PAD0);
#pragma unroll
      for (int i = 0; i < 8; ++i) {
        float c, s; sincos_rev(t * p->inv_d[i], c, s);
        const float x1 = v[i], x2 = v[i + 8];
        v[i] = x1 * c - x2 * s; v[i + 8] = x2 * c + x1 * s;
      }
    }
    st_bf8(ptr, v); st_bf8(ptr + 8, v + 8);
  }
}

DI void phase_p3(PmK p, int l, char* lds) {
  LAUNDER(p);
  const int tid_ = otid(), wid = tid_ >> 6, lane = tid_ & 63;
  float* wl = (float*)lds + wid * 2048;
  float* sq = wl; float* sa = wl + 768; float* sk = wl + 1440; float* scs = wl + 1952; float* ssn = wl + 1968;
  bf16_t* mq = (bf16_t*)(p->ws + OFF_MQ); bf16_t* mk = (bf16_t*)(p->ws + OFF_MK);
  const bf16_t* pa = (const bf16_t*)(p->ws + OFF_PA); const bf16_t* knr = (const bf16_t*)(p->ws + OFF_KNR);
  const float* qg = p->q_head_g + l * 96; const float* kg = p->k_head_g + l * 96;
  const float qscale = 0.10206207261596577f * LOG2E;
  const int h = lane >> 3, e0 = (lane & 7) * 12;
  for (int r = blockIdx.x * 8 + wid; r < R; r += gridDim.x * 8) {
    const int b = r / TP, pp = r - b * TP;
    for (int i = lane; i < 192; i += 64) { const f32x4 v = ld_bf4(mq + (size_t)r * 768 + i * 4); *(f32x4*)(sq + i * 4) = v; }
    for (int i = lane; i < 168; i += 64) { const f32x4 v = ld_bf4(pa + (size_t)r * 672 + i * 4); *(f32x4*)(sa + i * 4) = v; }
    for (int i = lane; i < 128; i += 64) { const f32x4 v = ld_bf4(knr + (size_t)r * 512 + i * 4); *(f32x4*)(sk + i * 4) = v; }
    if (lane < 16) { float c, s; sincos_rev((float)(pp - PAD0) * p->inv_m[lane], c, s); scs[lane] = c; ssn[lane] = s; }
    __syncthreads();
    float s1 = 0.f, s2 = 0.f;
    for (int i = lane; i < 384; i += 64) s1 += sa[i] * sa[i];
    for (int i = lane; i < 256; i += 64) s2 += sa[384 + i] * sa[384 + i];
    s1 = wsum(s1); s2 = wsum(s2);
    const float rq = rsqrtf(s1 * (1.f / 384.f) + 1e-6f), rkv = rsqrtf(s2 * (1.f / 256.f) + 1e-6f);
    float ssq = 0.f, ssk = 0.f;
#pragma unroll
    for (int e = 0; e < 12; ++e) {
      const int d = e0 + e; const float qv = sq[h * 96 + d] * rq; ssq += qv * qv;
      const float kv = d < 32 ? sa[640 + d] : sk[h * 64 + d - 32] * rkv; ssk += kv * kv;
    }
    ssq += __shfl_xor(ssq, 1); ssq += __shfl_xor(ssq, 2); ssq += __shfl_xor(ssq, 4);
    ssk += __shfl_xor(ssk, 1); ssk += __shfl_xor(ssk, 2); ssk += __shfl_xor(ssk, 4);
    const float nq = rsqrtf(ssq * (1.f / 96.f) + 1e-6f) * rq * qscale, nk = rsqrtf(ssk * (1.f / 96.f) + 1e-6f);
    float oq[12], ok[12];
#pragma unroll
    for (int e = 0; e < 12; ++e) {
      const int d = e0 + e;
      auto qn = [&](int dd) { return sq[h * 96 + dd] * nq * qg[dd]; };
      auto kn = [&](int dd) { return (dd < 32 ? sa[640 + dd] : sk[h * 64 + dd - 32] * rkv) * nk * kg[dd]; };
      if (d < 16) { oq[e] = qn(d) * scs[d] - qn(d + 16) * ssn[d]; ok[e] = kn(d) * scs[d] - kn(d + 16) * ssn[d]; }
      else if (d < 32) { oq[e] = qn(d) * scs[d - 16] + qn(d - 16) * ssn[d - 16]; ok[e] = kn(d) * scs[d - 16] + kn(d - 16) * ssn[d - 16]; }
      else { oq[e] = qn(d); ok[e] = kn(d); }
    }
    __syncthreads();
    bf16_t* dq = mq + (size_t)r * 768 + lane * 12; bf16_t* dk = mk + (size_t)r * 768 + lane * 12;
#pragma unroll
    for (int e = 0; e < 12; e += 4) { st_bf4(dq + e, (f32x4){oq[e], oq[e + 1], oq[e + 2], oq[e + 3]}); st_bf4(dk + e, (f32x4){ok[e], ok[e + 1], ok[e + 2], ok[e + 3]}); }
    __syncthreads();
  }
}

DI void phase_p2y(PmK p, int l) {
  LAUNDER(p);
  const int tid_ = otid(), wid = tid_ >> 6, lane = tid_ & 63;
  const bf16_t* xr = (const bf16_t*)(p->ws + OFF_XBCR); bf16_t* xc = (bf16_t*)(p->ws + OFF_XBCC); float* gates = (float*)(p->ws + OFF_GATES);
  const float* cw = p->conv_w + (size_t)l * 5 * 768; const float* cb = p->conv_b + l * 768;
  const int c0 = lane * 12;
  for (int r = blockIdx.x * 8 + wid; r < R; r += gridDim.x * 8) {
    const int b = r / TP, pp = r - b * TP;
    bf16_t* dst = xc + (size_t)r * 768 + c0;
    if (pp < PAD0) {
      const uint2 z = {0u, 0u};
      *(uint2*)dst = z; *(uint2*)(dst + 4) = z; *(uint2*)(dst + 8) = z;
      if (lane < 32) gates[(size_t)r * 32 + lane] = lane < 16 ? 0.f : (lane < 24 ? NEGF : 0.f);
      continue;
    }
    float acc[12];
#pragma unroll
    for (int e = 0; e < 12; ++e) acc[e] = cb[c0 + e];
#pragma unroll
    for (int j = 0; j < 5; ++j) {
      const int q = pp + j - 2;
      if (q >= PAD0 && q < TP) {
        const bf16_t* src = xr + (size_t)(r + j - 2) * 768 + c0;
#pragma unroll
        for (int e = 0; e < 12; e += 4) { const f32x4 v = ld_bf4(src + e);
          acc[e] += cw[j * 768 + c0 + e] * v[0]; acc[e + 1] += cw[j * 768 + c0 + e + 1] * v[1]; acc[e + 2] += cw[j * 768 + c0 + e + 2] * v[2]; acc[e + 3] += cw[j * 768 + c0 + e + 3] * v[3]; }
      }
    }
#pragma unroll
    for (int e = 0; e < 12; e += 4) st_bf4(dst + e, (f32x4){siluf(acc[e]), siluf(acc[e + 1]), siluf(acc[e + 2]), siluf(acc[e + 3])});
    if (lane < 32) {
      float v = gates[(size_t)r * 32 + lane];
      if (lane < 16) v = softplusf(v + p->dt_bias[l * 16 + lane]);
      else if (lane < 24) v = v + p->i_bias[l * 8 + lane - 16];
      else v = -softplusf(-(v + p->f_bias[l * 8 + lane - 24]));
      gates[(size_t)r * 32 + lane] = v;
    }
  }
}

DI void phase_post(PmK p, int l) {
  LAUNDER(p);
  const int tid_ = otid(), wid = tid_ >> 6, lane = tid_ & 63;
  bf16_t* mixed = (bf16_t*)(p->ws + OFF_MIXED); const bf16_t* sz = (const bf16_t*)(p->ws + OFF_SZ); const bf16_t* mo = (const bf16_t*)(p->ws + OFF_MQKVO);
  const float one_m_l = 1.f - p->linit[l];
  for (int r = blockIdx.x * 8 + wid; r < R; r += gridDim.x * 8) {
    const int b = r / TP, pp = r - b * TP;
    if (pp < PAD0) continue;
    bf16_t* row = mixed + (size_t)r * 2048 + lane * 8;
    float v[8], z[8];
    {
      ld_bf8(row, v); float ss = 0.f;
#pragma unroll
      for (int e = 0; e < 8; ++e) ss += v[e] * v[e];
      ss = wsum(ss); const float rn = rsqrtf(ss * (1.f / 512.f) + 1e-6f);
#pragma unroll
      for (int e = 0; e < 8; ++e) v[e] *= rn * p->mla_out_g[l * 512 + lane * 8 + e];
      if (ZB == 0) { for (int e = 0; e < 8; ++e) v[e] = 0.f; }
      st_bf8(row, v);
    }
    {
      ld_bf8(row + 512, v); ld_bf8(sz + (size_t)r * 512 + lane * 8, z); float ss = 0.f;
#pragma unroll
      for (int e = 0; e < 8; ++e) { v[e] *= siluf(z[e]); ss += v[e] * v[e]; }
      ss = wsum(ss); const float rn = rsqrtf(ss * (1.f / 512.f) + 1e-6f);
#pragma unroll
      for (int e = 0; e < 8; ++e) v[e] *= rn * p->ssd_norm_g[l * 512 + lane * 8 + e];
      if (ZB == 1) { for (int e = 0; e < 8; ++e) v[e] = 0.f; }
      st_bf8(row + 512, v);
    }
    {
      ld_bf8(row + 1024, v); float ss = 0.f;
#pragma unroll
      for (int e = 0; e < 8; ++e) ss += v[e] * v[e];
      ss += __shfl_xor(ss, 1); ss += __shfl_xor(ss, 2); ss += __shfl_xor(ss, 4); ss += __shfl_xor(ss, 8);
      const float rn = rsqrtf(ss * (1.f / 128.f) + 1e-6f) * one_m_l;
#pragma unroll
      for (int e = 0; e < 8; ++e) v[e] *= rn * p->dout_g[l * 128 + (lane & 15) * 8 + e];
      if (ZB == 2) { for (int e = 0; e < 8; ++e) v[e] = 0.f; }
      st_bf8(row + 1024, v);
    }
    {
      ld_bf8(row + 1536, v); ld_bf8(mo + (size_t)r * 1536 + 1024 + lane * 8, z); float ss = 0.f;
#pragma unroll
      for (int e = 0; e < 8; ++e) ss += v[e] * v[e];
      ss += __shfl_xor(ss, 1); ss += __shfl_xor(ss, 2); ss += __shfl_xor(ss, 4); ss += __shfl_xor(ss, 8);
      const float rn = rsqrtf(ss * (1.f / 128.f) + 1e-6f);
#pragma unroll
      for (int e = 0; e < 8; ++e) v[e] *= rn * p->ml_out_g[l * 128 + (lane & 15) * 8 + e] * sigmf(z[e]);
      if (ZB == 3) { for (int e = 0; e < 8; ++e) v[e] = 0.f; }
      st_bf8(row + 1536, v);
    }
  }
}

DI void vtrans_items(PmK p, char* lds) {
  LAUNDER(p);
  const int tid = otid();
  bf16_t* T = (bf16_t*)lds;
  float* s_r = (float*)(T + 64 * 520);
  const bf16_t* pa = (const bf16_t*)(p->ws + OFF_PA); const bf16_t* mvr = (const bf16_t*)(p->ws + OFF_MVR); const bf16_t* dqkv = (const bf16_t*)(p->ws + OFF_DQKV);
  bf16_t* mvt = (bf16_t*)(p->ws + OFF_MVT); bf16_t* dvt = (bf16_t*)(p->ws + OFF_DVT);
  for (int it = blockIdx.x; it < 2 * NB * 130; it += gridDim.x) {
    const int which = it / (NB * 130), rem = it - which * (NB * 130), b = rem / 130, pc = rem - b * 130, r0 = b * TP + pc * 64;
    __syncthreads();
    if (which == 0) {
      const int row = tid >> 3, sub = tid & 7; float ss = 0.f;
#pragma unroll
      for (int e = 0; e < 4; ++e) { float v[8]; ld_bf8(pa + (size_t)(r0 + row) * 672 + 384 + sub * 32 + e * 8, v);
#pragma unroll
        for (int q = 0; q < 8; ++q) ss += v[q] * v[q]; }
      ss += __shfl_xor(ss, 1); ss += __shfl_xor(ss, 2); ss += __shfl_xor(ss, 4);
      if (sub == 0) s_r[row] = rsqrtf(ss * (1.f / 256.f) + 1e-6f);
    }
    __syncthreads();
    const bf16_t* src = which ? dqkv + 1024 : mvr; const int ld = which ? 1536 : 512;
#pragma unroll
    for (int i = 0; i < 8; ++i) {
      const int id = tid + 512 * i, row = id >> 6, cc = id & 63;
      if (which) *(uint4*)(T + row * 520 + cc * 8) = *(const uint4*)(src + (size_t)(r0 + row) * ld + cc * 8);
      else { float v[8]; ld_bf8(src + (size_t)(r0 + row) * ld + cc * 8, v); const float sc = s_r[row];
#pragma unroll
        for (int q = 0; q < 8; ++q) v[q] *= sc;
        st_bf8(T + row * 520 + cc * 8, v); }
    }
    __syncthreads();
    bf16_t* dT = (which ? dvt : mvt) + (size_t)b * 512 * TP + pc * 64;
#pragma unroll
    for (int i = 0; i < 8; ++i) {
      const int id = tid + 512 * i, c = id >> 3, pch = id & 7;
      bf16x8 o;
#pragma unroll
      for (int e = 0; e < 8; ++e) o[e] = (short)T[(pch * 8 + e) * 520 + c];
      *(bf16x8*)(dT + (size_t)c * TP + pch * 8) = o;
    }
  }
  __syncthreads();
}

typedef float f32x16 __attribute__((ext_vector_type(16)));
#define MFMA32(a, b, c) __builtin_amdgcn_mfma_f32_32x32x16_bf16((a), (b), (c), 0, 0, 0)
DI int crow(int i, int hi) { return (i & 3) + 8 * (i >> 2) + 4 * hi; }

template <int DQK, int DV, bool SECOND>
DI void attn32(char* lds, const bf16_t* __restrict__ Qb, int ldq, const bf16_t* __restrict__ Kb, int ldk, const bf16_t* __restrict__ VTb, int q0,
               bf16_t* dstb, float lam) {
  constexpr int KS = DQK + 8, VS = 72, NKS = DQK / 16, NDB = DV / 32, KCH = DQK / 8;
  constexpr int NK = 64 * KCH, NV = DV * 8, NCHK = NK + NV, CI = (NCHK + 511) / 512, NT = TP / 64, BUF = 64 * KS + DV * VS;
  bf16_t* L = (bf16_t*)lds;
  const int tid = otid(), wid = tid >> 6, lane = tid & 63, r32 = lane & 31, hi = lane >> 5;
  const int prow = q0 + 32 * wid + r32, pc = prow < 0 ? 0 : prow;
  bf16x8 qf[NKS];
#pragma unroll
  for (int ks = 0; ks < NKS; ++ks) qf[ks] = *(const bf16x8*)(Qb + (size_t)pc * ldq + 16 * ks + 8 * hi);
  f32x16 o[NDB];
#pragma unroll
  for (int db = 0; db < NDB; ++db)
#pragma unroll
    for (int i = 0; i < 16; ++i) o[db][i] = 0.f;
  float m = NEGF, lsum = 0.f;
  bf16x8 st[CI];
#define A32_GLOAD(kt) do { _Pragma("unroll") for (int i = 0; i < CI; ++i) { const int id = tid + 512 * i; if (id < NCHK) { \
      if (id < NK) { const int row = id / KCH, cc = id - row * KCH; st[i] = *(const bf16x8*)(Kb + (size_t)((kt) * 64 + row) * ldk + cc * 8); } \
      else { const int v = id - NK, d = v >> 3, cc = v & 7; st[i] = *(const bf16x8*)(VTb + (size_t)d * TP + (kt) * 64 + cc * 8); } } } } while (0)
#define A32_LSTORE(buf) do { _Pragma("unroll") for (int i = 0; i < CI; ++i) { const int id = tid + 512 * i; if (id < NCHK) { \
      if (id < NK) { const int row = id / KCH, cc = id - row * KCH; *(bf16x8*)(L + (buf) * BUF + row * KS + cc * 8) = st[i]; } \
      else { const int v = id - NK, d = v >> 3, cc = v & 7; *(bf16x8*)(L + (buf) * BUF + 64 * KS + d * VS + cc * 8) = st[i]; } } } } while (0)
  A32_GLOAD(1); A32_LSTORE(1); __syncthreads(); A32_GLOAD(2);
#pragma unroll 1
  for (int kt = 1; kt < NT; ++kt) {
    const bf16_t* Ks = L + (kt & 1) * BUF; const bf16_t* Vt = Ks + 64 * KS;
    f32x16 s0, s1;
#pragma unroll
    for (int i = 0; i < 16; ++i) { s0[i] = 0.f; s1[i] = 0.f; }
#pragma unroll
    for (int ks = 0; ks < NKS; ++ks) {
      const bf16x8 ka0 = *(const bf16x8*)(Ks + r32 * KS + 16 * ks + 8 * hi), ka1 = *(const bf16x8*)(Ks + (32 + r32) * KS + 16 * ks + 8 * hi);
      s0 = MFMA32(ka0, qf[ks], s0); s1 = MFMA32(ka1, qf[ks], s1);
    }
    if (kt == 1) {
#pragma unroll
      for (int i = 0; i < 16; ++i) { if (crow(i, hi) < 48) s0[i] = NEGF; if (32 + crow(i, hi) < 48) s1[i] = NEGF; }
    }
    float mx = s0[0];
#pragma unroll
    for (int i = 1; i < 16; ++i) mx = fmaxf(mx, s0[i]);
#pragma unroll
    for (int i = 0; i < 16; ++i) mx = fmaxf(mx, s1[i]);
    mx = fmaxf(mx, __shfl_xor(mx, 32));
    const float mn = fmaxf(m, mx), alpha = __builtin_amdgcn_exp2f(m - mn); m = mn;
    float rs = 0.f;
#pragma unroll
    for (int i = 0; i < 16; ++i) { s0[i] = __builtin_amdgcn_exp2f(s0[i] - mn); rs += s0[i]; }
#pragma unroll
    for (int i = 0; i < 16; ++i) { s1[i] = __builtin_amdgcn_exp2f(s1[i] - mn); rs += s1[i]; }
    lsum = lsum * alpha + rs;
#pragma unroll
    for (int db = 0; db < NDB; ++db) o[db] *= alpha;
    bf16x8 pb[4];
#pragma unroll
    for (int s4 = 0; s4 < 4; ++s4) {
      const int b8 = 8 * (s4 & 1);
      u32x4 w;
      if (s4 < 2) w = (u32x4){cvt_pk(s0[b8], s0[b8 + 1]), cvt_pk(s0[b8 + 2], s0[b8 + 3]), cvt_pk(s0[b8 + 4], s0[b8 + 5]), cvt_pk(s0[b8 + 6], s0[b8 + 7])};
      else w = (u32x4){cvt_pk(s1[b8], s1[b8 + 1]), cvt_pk(s1[b8 + 2], s1[b8 + 3]), cvt_pk(s1[b8 + 4], s1[b8 + 5]), cvt_pk(s1[b8 + 6], s1[b8 + 7])};
      pb[s4] = __builtin_bit_cast(bf16x8, w);
    }
#pragma unroll
    for (int db = 0; db < NDB; ++db)
#pragma unroll
      for (int s4 = 0; s4 < 4; ++s4) {
        const bf16_t* vp = Vt + (db * 32 + r32) * VS + 16 * s4 + 4 * hi;
        const uint2 a = *(const uint2*)vp, b = *(const uint2*)(vp + 8);
        u32x4 w = {a.x, a.y, b.x, b.y};
        o[db] = MFMA32(__builtin_bit_cast(bf16x8, w), pb[s4], o[db]);
      }
    if (kt + 1 < NT) A32_LSTORE((kt + 1) & 1);
    __syncthreads();
    if (kt + 2 < NT) A32_GLOAD(kt + 2);
  }
#undef A32_GLOAD
#undef A32_LSTORE
  lsum += __shfl_xor(lsum, 32);
  const float il = 1.f / lsum;
  if (prow >= PAD0) {
    bf16_t* drow = dstb + (size_t)prow * 2048 + 4 * hi;
#pragma unroll
    for (int db = 0; db < NDB; ++db)
#pragma unroll
      for (int g = 0; g < 4; ++g) {
        f32x4 v = {o[db][4 * g] * il, o[db][4 * g + 1] * il, o[db][4 * g + 2] * il, o[db][4 * g + 3] * il};
        bf16_t* ad = drow + db * 32 + 8 * g;
        if (SECOND) { const f32x4 pv = ld_bf4(ad); v = pv - lam * v; }
        st_bf4(ad, v);
      }
  }
  __syncthreads();
}

DI void phase_attn(PmK p, char* lds) {
  LAUNDER(p);
  const int tid = otid();
  bf16_t* mixed = (bf16_t*)(p->ws + OFF_MIXED);
  const bf16_t* dqkv = (const bf16_t*)(p->ws + OFF_DQKV);
  const bf16_t* mq = (const bf16_t*)(p->ws + OFF_MQ); const bf16_t* mk = (const bf16_t*)(p->ws + OFF_MK);
  const bf16_t* mvt = (const bf16_t*)(p->ws + OFF_MVT); const bf16_t* dvt = (const bf16_t*)(p->ws + OFF_DVT);
  const float lam = ((const float*)(p->ws + OFF_SCAL))[0];
  int* counter = (int*)(p->ws + OFF_SCAL) + 16;
  int* s_it = (int*)(lds + 120 * 1024);
  constexpr int NQ = 33, ND = NB * 4 * NQ, NM = NB * 8 * NQ;
  for (;;) {
    __syncthreads();
    if (tid == 0) *s_it = atomicAdd(counter, 1);
    __syncthreads();
    const int it = *s_it;
    if (it >= ND + NM) break;
    if (it < ND) {
      const int qi = it % NQ, bh = it / NQ, h = bh & 3, b = bh >> 2, q0 = 256 * qi - 128;
      const bf16_t* base = dqkv + (size_t)b * TP * 1536;
      const bf16_t* vt = dvt + ((size_t)b * 512 + h * 128) * TP;
      bf16_t* dst = mixed + (size_t)b * TP * 2048 + 1024 + h * 128;
      attn32<64, 128, false>(lds, base + (2 * h) * 64, 1536, base + 512 + (2 * h) * 64, 1536, vt, q0, dst, lam);
      attn32<64, 128, true>(lds, base + (2 * h + 1) * 64, 1536, base + 512 + (2 * h + 1) * 64, 1536, vt, q0, dst, lam);
    } else {
      const int i2 = it - ND, qi = i2 % NQ, bh = i2 / NQ, h = bh & 7, b = bh >> 3, q0 = 256 * qi - 128;
      attn32<96, 64, false>(lds, mq + (size_t)b * TP * 768 + h * 96, 768, mk + (size_t)b * TP * 768 + h * 96, 768, mvt + ((size_t)b * 512 + h * 64) * TP, q0,
                            mixed + (size_t)b * TP * 2048 + h * 64, lam);
    }
  }
}

DI void phase_states(PmK p, int l, char* lds) {
  LAUNDER(p);
  const int tid = otid(), wid = tid >> 6, lane = tid & 63, fr = lane & 15, fq = lane >> 4;
  const bf16_t* xc = (const bf16_t*)(p->ws + OFF_XBCC); const float* gates = (const float*)(p->ws + OFF_GATES);
  const bf16_t* mqk = (const bf16_t*)(p->ws + OFF_MQKVO);
  float* ssds = (float*)(p->ws + OFF_SSDS); float* ssdd = (float*)(p->ws + OFF_SSDD);
  float* mls = (float*)(p->ws + OFF_MLS); float* mlg = (float*)(p->ws + OFF_MLG);
  bf16_t* T0 = (bf16_t*)lds;
  bf16_t* T1 = T0 + 64 * 136;
  float* s_a = (float*)(T1 + 144 * 136); float* s_b = s_a + 128; float* s_cum = s_b + 128; float* s_sc = s_cum + 128;
  constexpr int NS = NB * NCH * 8 * 2, NMI = NB * NCH * 4 * 2;
  for (int it = blockIdx.x; it < NS + NMI; it += gridDim.x) {
    __syncthreads();
    if (it < NS) {
      const int dir = it & 1, hh = (it >> 1) & 7, bc = it >> 4, c = bc % NCH, b = bc / NCH, g = hh >> 2;
      const int r0 = b * TP + c * 128;
      const float Ah = -expf(p->a_log[l * 16 + dir * 8 + hh]);
      if (tid < 128) { const float dtv = gates[(size_t)(r0 + tid) * 32 + dir * 8 + hh]; s_b[tid] = dtv; s_a[tid] = dtv * Ah; }
      __syncthreads();
      if (wid == 0) scan128_sum(s_a, s_cum, dir, lane);
      __syncthreads();
      const float tot = dir ? s_cum[0] : s_cum[127];
#pragma unroll
      for (int i = 0; i < 2; ++i) {
        const int id = tid + 512 * i, lrow = id >> 3, c8 = id & 7;
        float xv[8]; ld_bf8(xc + (size_t)(r0 + lrow) * 768 + hh * 64 + c8 * 8, xv);
        const uint4 bw = *(const uint4*)(xc + (size_t)(r0 + lrow) * 768 + 512 + g * 64 + c8 * 8);
        const bf16x8 bv = __builtin_bit_cast(bf16x8, bw);
        const float sc = s_b[lrow] * fexp(tot - s_cum[lrow]);
#pragma unroll
        for (int e = 0; e < 8; ++e) { T0[(c8 * 8 + e) * 136 + lrow] = f2bf(xv[e] * sc); T1[(c8 * 8 + e) * 136 + lrow] = (bf16_t)bv[e]; }
      }
      __syncthreads();
      const int cp = dir ? NCH - 1 - c : c;
      const size_t sidx = (size_t)((b * 8 + hh) * 2 + dir) * NCH + cp;
      for (int t = wid; t < 16; t += 8) {
        const int nt = t & 3, pt = t >> 2;
        const f32x4 acc = mma_lds(T1 + nt * 16 * 136, 136, T0 + pt * 16 * 136, 136, 128, (f32x4){0.f, 0.f, 0.f, 0.f}, fr, fq);
        *(f32x4*)(ssds + sidx * 4096 + (pt * 16 + fr) * 64 + nt * 16 + 4 * fq) = acc;
      }
      if (tid == 0) ssdd[sidx] = fexp(tot);
    } else {
      const int i2 = it - NS, dir = i2 & 1, hm = (i2 >> 1) & 3, bc = i2 >> 3, c = bc % NCH, b = bc / NCH;
      const int r0 = b * TP + c * 128;
      if (tid < 128) { s_a[tid] = gates[(size_t)(r0 + tid) * 32 + 24 + dir * 4 + hm]; s_b[tid] = gates[(size_t)(r0 + tid) * 32 + 16 + dir * 4 + hm]; }
      __syncthreads();
      if (wid == 0) scan128_sum(s_a, s_cum, dir, lane);
      __syncthreads();
      const float glast = dir ? s_cum[0] : s_cum[127];
      if (wid == 0) {
        float mx = fmaxf(glast - s_cum[lane] + s_b[lane], glast - s_cum[lane + 64] + s_b[lane + 64]);
        mx = wmax(mx); if (lane == 0) s_sc[0] = mx;
      }
      __syncthreads();
      const float mloc = s_sc[0];
#pragma unroll
      for (int i = 0; i < 2; ++i) {
        const int id = tid + 512 * i, lrow = id >> 3, c8 = id & 7;
        const uint4 kw = *(const uint4*)(mqk + (size_t)(r0 + lrow) * 1536 + 256 + hm * 64 + c8 * 8);
        const bf16x8 kv = __builtin_bit_cast(bf16x8, kw);
#pragma unroll
        for (int e = 0; e < 8; ++e) T0[(c8 * 8 + e) * 136 + lrow] = (bf16_t)kv[e];
      }
#pragma unroll
      for (int i = 0; i < 4; ++i) {
        const int id = tid + 512 * i, lrow = id >> 4, c8 = id & 15;
        float vv[8]; ld_bf8(mqk + (size_t)(r0 + lrow) * 1536 + 512 + hm * 128 + c8 * 8, vv);
        const float w = fexp(glast - s_cum[lrow] + s_b[lrow] - mloc);
#pragma unroll
        for (int e = 0; e < 8; ++e) T1[(c8 * 8 + e) * 136 + lrow] = f2bf(vv[e] * w);
      }
      for (int id = tid; id < 16 * 128; id += 512) {
        const int vr = id >> 7, lrow = id & 127;
        T1[(128 + vr) * 136 + lrow] = vr == 0 ? f2bf(fexp(glast - s_cum[lrow] + s_b[lrow] - mloc)) : (bf16_t)0;
      }
      __syncthreads();
      const int cp = dir ? NCH - 1 - c : c;
      const size_t sidx = (size_t)((b * 4 + hm) * 2 + dir) * NCH + cp;
      for (int t = wid; t < 36; t += 8) {
        const int dt_ = t & 3, vt = t >> 2;
        const f32x4 acc = mma_lds(T0 + dt_ * 16 * 136, 136, T1 + vt * 16 * 136, 136, 128, (f32x4){0.f, 0.f, 0.f, 0.f}, fr, fq);
        *(f32x4*)(mls + sidx * 9216 + (vt * 16 + fr) * 64 + dt_ * 16 + 4 * fq) = acc;
      }
      if (tid == 0) { mlg[sidx * 3] = glast; mlg[sidx * 3 + 1] = mloc; }
    }
  }
  __syncthreads();
}

DI void phase_scan(PmK p) {
  LAUNDER(p);
  float* ssds = (float*)(p->ws + OFF_SSDS); const float* ssdd = (const float*)(p->ws + OFF_SSDD);
  float* mls = (float*)(p->ws + OFF_MLS); float* mlg = (float*)(p->ws + OFF_MLG);
  const int gt = blockIdx.x * 512 + threadIdx.x, gn = gridDim.x * 512;
  for (int e = gt; e < 64 * 4096; e += gn) {
    const int chain = e >> 12, el = e & 4095; float run = 0.f;
    for (int cp = 0; cp < NCH; ++cp) {
      const size_t ix = (size_t)(chain * NCH + cp) * 4096 + el;
      const float t = ssds[ix]; ssds[ix] = run; run = run * ssdd[chain * NCH + cp] + t;
    }
  }
  for (int e = gt; e < 32 * 9216; e += gn) {
    const int chain = e / 9216, el = e - chain * 9216; float run = 0.f, m = NEGF;
    for (int cp = 0; cp < NCH; ++cp) {
      const int ci = chain * NCH + cp; const size_t ix = (size_t)ci * 9216 + el;
      const float gl = mlg[ci * 3], ml = mlg[ci * 3 + 1];
      const float t = mls[ix]; mls[ix] = run;
      if (el == 0) mlg[ci * 3 + 2] = m;
      const float mn = fmaxf(gl + m, ml);
      run = fexp(gl + m - mn) * run + fexp(ml - mn) * t; m = mn;
    }
  }
}

DI void phase_out(PmK p, int l, char* lds) {
  LAUNDER(p);
  const int tid = otid(), wid = tid >> 6, lane = tid & 63, fr = lane & 15, fq = lane >> 4;
  const bf16_t* xc = (const bf16_t*)(p->ws + OFF_XBCC); const float* gates = (const float*)(p->ws + OFF_GATES);
  const bf16_t* mqk = (const bf16_t*)(p->ws + OFF_MQKVO);
  const float* ssds = (const float*)(p->ws + OFF_SSDS); const float* mls = (const float*)(p->ws + OFF_MLS); const float* mlg = (const float*)(p->ws + OFF_MLG);
  bf16_t* mixed = (bf16_t*)(p->ws + OFF_MIXED);
  bf16_t* A0 = (bf16_t*)lds; bf16_t* A1 = A0 + 128 * 72; bf16_t* Vt = A1 + 128 * 72; bf16_t* Ms = Vt + 144 * 136; bf16_t* St = Ms + 128 * 136;
  float* s_a = (float*)(St + 144 * 72); float* s_b = s_a + 128; float* s_cum = s_b + 128; float* s_pm = s_cum + 128;
  constexpr int NS = NB * NCH * 8, NMI = NB * NCH * 4;
  const f32x4 zero4 = {0.f, 0.f, 0.f, 0.f};
  for (int it = blockIdx.x; it < NS; it += gridDim.x) {
    __syncthreads();
    {
      const int hh = it & 7, bc = it >> 3, c = bc % NCH, b = bc / NCH, g = hh >> 2;
      const int r0 = b * TP + c * 128;
#pragma unroll
      for (int i = 0; i < 2; ++i) {
        const int id = tid + 512 * i, lrow = id >> 3, c8 = id & 7;
        *(uint4*)(A0 + lrow * 72 + c8 * 8) = *(const uint4*)(xc + (size_t)(r0 + lrow) * 768 + 640 + g * 64 + c8 * 8);
        *(uint4*)(A1 + lrow * 72 + c8 * 8) = *(const uint4*)(xc + (size_t)(r0 + lrow) * 768 + 512 + g * 64 + c8 * 8);
      }
      __syncthreads();
      f32x4 yacc[4] = {zero4, zero4, zero4, zero4};
      const int lrow_me = 16 * wid + fr;
      for (int dir = 0; dir < 2; ++dir) {
        __syncthreads();
        const float Ah = -expf(p->a_log[l * 16 + dir * 8 + hh]);
        if (tid < 128) { const float dtv = gates[(size_t)(r0 + tid) * 32 + dir * 8 + hh]; s_b[tid] = dtv; s_a[tid] = dtv * Ah; }
        __syncthreads();
        if (wid == 0) scan128_sum(s_a, s_cum, dir, lane);
        __syncthreads();
#pragma unroll
        for (int i = 0; i < 2; ++i) {
          const int id = tid + 512 * i, lrow = id >> 3, c8 = id & 7;
          float xv[8]; ld_bf8(xc + (size_t)(r0 + lrow) * 768 + hh * 64 + c8 * 8, xv);
          const float sc = s_b[lrow];
#pragma unroll
          for (int e = 0; e < 8; ++e) Vt[(c8 * 8 + e) * 136 + lrow] = f2bf(xv[e] * sc);
        }
        const int cp = dir ? NCH - 1 - c : c;
        const size_t sidx = (size_t)((b * 8 + hh) * 2 + dir) * NCH + cp;
#pragma unroll
        for (int i = 0; i < 2; ++i) {
          const int id = tid + 512 * i;
          const f32x4 v = *(const f32x4*)(ssds + sidx * 4096 + id * 4);
          st_bf4(St + (id >> 4) * 72 + (id & 15) * 4, v);
        }
        const float cl = s_cum[lrow_me];
        int lrow_v = lrow_me; asm volatile("" : "+v"(lrow_v));
#pragma unroll 1
        for (int st = 0; st < 8; ++st) {
          f32x4 mv;
          const f32x4 gt_ = mma_lds(A1 + st * 16 * 72, 72, A0 + wid * 16 * 72, 72, 64, zero4, fr, fq);
#pragma unroll
          for (int j = 0; j < 4; ++j) {
            const int s = 16 * st + 4 * fq + j;
            const bool ok = dir ? (s >= lrow_v) : (s <= lrow_v);
            mv[j] = ok ? gt_[j] * fexp(fminf(cl - s_cum[s], 0.f)) : 0.f;
          }
          st_bf4(Ms + lrow_me * 136 + 16 * st + 4 * fq, mv);
        }
        __syncthreads();
        const float el = fexp(cl);
#pragma unroll
        for (int pt = 0; pt < 4; ++pt) {
          const f32x4 a1 = mma_lds(Vt + pt * 16 * 136, 136, Ms + wid * 16 * 136, 136, 128, zero4, fr, fq);
          const f32x4 a2 = mma_lds(St + pt * 16 * 72, 72, A0 + wid * 16 * 72, 72, 64, zero4, fr, fq);
          yacc[pt] += a1 + el * a2;
        }
      }
      const int pp = c * 128 + lrow_me;
      if (pp >= PAD0) {
        const float dsk = p->ssd_d[l * 8 + hh];
        const size_t r = (size_t)r0 + lrow_me;
#pragma unroll
        for (int pt = 0; pt < 4; ++pt) {
          const f32x4 xs = ld_bf4(xc + r * 768 + hh * 64 + pt * 16 + 4 * fq);
          st_bf4(mixed + r * 2048 + 512 + hh * 64 + pt * 16 + 4 * fq, yacc[pt] + dsk * xs);
        }
      }
    }
  }
  for (int i2 = (blockIdx.x + 32) % gridDim.x; i2 < NMI; i2 += gridDim.x) {
    __syncthreads();
    {
      const int hm = i2 & 3, bc = i2 >> 2, c = bc % NCH, b = bc / NCH;
      const int r0 = b * TP + c * 128;
#pragma unroll
      for (int i = 0; i < 2; ++i) {
        const int id = tid + 512 * i, lrow = id >> 3, c8 = id & 7;
        float qv[8]; ld_bf8(mqk + (size_t)(r0 + lrow) * 1536 + hm * 64 + c8 * 8, qv);
#pragma unroll
        for (int e = 0; e < 8; ++e) qv[e] *= 0.125f;
        st_bf8(A0 + lrow * 72 + c8 * 8, qv);
        *(uint4*)(A1 + lrow * 72 + c8 * 8) = *(const uint4*)(mqk + (size_t)(r0 + lrow) * 1536 + 256 + hm * 64 + c8 * 8);
      }
#pragma unroll
      for (int i = 0; i < 4; ++i) {
        const int id = tid + 512 * i, lrow = id >> 4, c8 = id & 15;
        const uint4 vw = *(const uint4*)(mqk + (size_t)(r0 + lrow) * 1536 + 512 + hm * 128 + c8 * 8);
        const bf16x8 vv = __builtin_bit_cast(bf16x8, vw);
#pragma unroll
        for (int e = 0; e < 8; ++e) Vt[(c8 * 8 + e) * 136 + lrow] = (bf16_t)vv[e];
      }
      for (int id = tid; id < 16 * 128; id += 512) { const int vr = id >> 7, lrow = id & 127; Vt[(128 + vr) * 136 + lrow] = vr == 0 ? (bf16_t)0x3f80 : (bf16_t)0; }
      __syncthreads();
      f32x4 hacc[8];
#pragma unroll
      for (int vt = 0; vt < 8; ++vt) hacc[vt] = zero4;
      const int lrow_me = 16 * wid + fr;
      for (int dir = 0; dir < 2; ++dir) {
        __syncthreads();
        if (tid < 128) { s_a[tid] = gates[(size_t)(r0 + tid) * 32 + 24 + dir * 4 + hm]; s_b[tid] = gates[(size_t)(r0 + tid) * 32 + 16 + dir * 4 + hm]; }
        __syncthreads();
        if (wid == 0) scan128_sum(s_a, s_cum, dir, lane);
        __syncthreads();
        if (tid < 128) s_a[tid] = s_b[tid] - s_cum[tid];
        __syncthreads();
        if (wid == 0) scan128_max(s_a, s_pm, dir, lane);
        const int cp = dir ? NCH - 1 - c : c;
        const size_t sidx = (size_t)((b * 4 + hm) * 2 + dir) * NCH + cp;
        for (int id = tid; id < 2304; id += 512) {
          const f32x4 v = *(const f32x4*)(mls + sidx * 9216 + id * 4);
          st_bf4(St + (id >> 4) * 72 + (id & 15) * 4, v);
        }
        const float mst = mlg[sidx * 3 + 2];
        __syncthreads();
        const float cl = s_cum[lrow_me];
        int lrow_v = lrow_me; asm volatile("" : "+v"(lrow_v));
        const float mrow = cl + fmaxf(s_pm[lrow_me], mst);
        const float winter = fexp(fminf(cl + mst - mrow, 0.f));
#pragma unroll 1
        for (int st = 0; st < 8; ++st) {
          f32x4 mv;
          const f32x4 s0_ = mma_lds(A1 + st * 16 * 72, 72, A0 + wid * 16 * 72, 72, 64, zero4, fr, fq);
#pragma unroll
          for (int j = 0; j < 4; ++j) {
            const int s = 16 * st + 4 * fq + j;
            const bool ok = dir ? (s >= lrow_v) : (s <= lrow_v);
            mv[j] = ok ? s0_[j] * fexp(fminf(cl + s_a[s] - mrow, 0.f)) : 0.f;
          }
          st_bf4(Ms + lrow_me * 136 + 16 * st + 4 * fq, mv);
        }
        __syncthreads();
        float dd;
        {
          const f32x4 a1 = mma_lds(Vt + 8 * 16 * 136, 136, Ms + wid * 16 * 136, 136, 128, zero4, fr, fq);
          const f32x4 a2 = mma_lds(St + 8 * 16 * 72, 72, A0 + wid * 16 * 72, 72, 64, zero4, fr, fq);
          const float den = __shfl(a1[0] + winter * a2[0], fr);
          dd = 1.f / fmaxf(fabsf(den), fexp(-mrow));
        }
#pragma unroll
        for (int vt = 0; vt < 8; ++vt) {
          const f32x4 a1 = mma_lds(Vt + vt * 16 * 136, 136, Ms + wid * 16 * 136, 136, 128, zero4, fr, fq);
          const f32x4 a2 = mma_lds(St + vt * 16 * 72, 72, A0 + wid * 16 * 72, 72, 64, zero4, fr, fq);
          hacc[vt] += (a1 + winter * a2) * dd;
        }
      }
      const int pp = c * 128 + lrow_me;
      if (pp >= PAD0) {
        const size_t r = (size_t)r0 + lrow_me;
#pragma unroll
        for (int vt = 0; vt < 8; ++vt) st_bf4(mixed + r * 2048 + 1536 + hm * 128 + vt * 16 + 4 * fq, hacc[vt]);
      }
    }
  }
  __syncthreads();
}


#ifndef DBGCHK
#define DBGCHK 0
#endif
#if DBGCHK
DI float blk_max(float v, float* red, int tid) {
  v = wmax(v); __syncthreads(); if ((tid & 63) == 0) red[tid >> 6] = v; __syncthreads();
  float r = red[0]; for (int i = 1; i < 8; ++i) r = fmaxf(r, red[i]); return r;
}
DI float blk_sum(float v, float* red, int tid) {
  v = wsum(v); __syncthreads(); if ((tid & 63) == 0) red[tid >> 6] = v; __syncthreads();
  float r = 0.f; for (int i = 0; i < 8; ++i) r += red[i]; return r;
}
DI void dbg_check_attn(PmK p, char* lds) {
  LAUNDER(p);
  const int tid = otid();
  float* w = (float*)lds; float* red = w + 8320;
  const int b = 1, j = 2, h = 1, pq = 5000;
  const bf16_t* base = (const bf16_t*)(p->ws + OFF_DQKV) + (size_t)b * TP * 1536;
  const bf16_t* mixed = (const bf16_t*)(p->ws + OFF_MIXED);
  float mx = NEGF;
  for (int t = PAD0 + tid; t < TP; t += 512) {
    float s = 0.f;
    for (int c = 0; c < 64; ++c) s += bf2f(base[(size_t)pq * 1536 + j * 64 + c]) * bf2f(base[(size_t)t * 1536 + 512 + j * 64 + c]);
    w[t] = s; mx = fmaxf(mx, s);
  }
  const float M = blk_max(mx, red, tid);
  float ls = 0.f;
  for (int t = PAD0 + tid; t < TP; t += 512) { const float e = __builtin_amdgcn_exp2f(w[t] - M); w[t] = e; ls += e; }
  const float L = blk_sum(ls, red, tid);
  __syncthreads();
  float err = 0.f, mag = 0.f;
  if (tid < 128) {
    float o = 0.f;
    for (int t = PAD0; t < TP; ++t) o += w[t] * bf2f(base[(size_t)t * 1536 + 1024 + h * 128 + tid]);
    o /= L;
    const float kv = bf2f(mixed[((size_t)b * TP + pq) * 2048 + 1024 + h * 128 + tid]);
    err = fabsf(o - kv); mag = fabsf(o);
  }
  const float E = blk_max(err, red, tid), G = blk_max(mag, red, tid);
  if (tid == 0) ((float*)(p->ws + OFF_SCAL))[8] = 1000.f + 1000.f * fminf(E / G, 50.f);
}

DI void dbg_check_p2x(PmK p, int l, char* lds) {
  LAUNDER(p);
  const int tid = otid();
  float* raw = (float*)lds; float* red = raw + 256;
  const int b = 1, pq = 5000, r = b * TP + pq;
  const bf16_t* hn = (const bf16_t*)(p->ws + OFF_HN); const bf16_t* win = (const bf16_t*)(p->ws + OFF_WIN);
  const bf16_t* dqkv = (const bf16_t*)(p->ws + OFF_DQKV);
  float err = 0.f, mag = 0.f;
  for (int hsel = 0; hsel < 2; ++hsel) {
    const int hd = hsel ? 19 : 17;
    __syncthreads();
    if (tid < 64) { float a = 0.f; for (int k = 0; k < 1024; ++k) a += bf2f(hn[(size_t)r * 1024 + k]) * bf2f(win[(size_t)(672 + hd * 64 + tid) * 1024 + k]); raw[tid] = a; }
    __syncthreads();
    if (tid < 64) {
      float ss = 0.f; for (int c = 0; c < 64; ++c) ss += raw[c] * raw[c];
      const float rinv = rsqrtf(ss / 64.f + 1e-6f) * (hd < 8 ? 0.125f * LOG2E : 1.f);
      const float* g = (hd < 8 ? p->dq_g : p->dk_g) + l * 64; if (hd >= 16) g = p->dq_g;
      auto nv = [&](int c) { return raw[c] * rinv * g[c]; };
      float o = nv(tid);
      if (tid < 16) { const int i = tid & 7; float cs, sn; sincos_rev((float)(pq - PAD0) * p->inv_d[i], cs, sn);
        o = tid < 8 ? nv(tid) * cs - nv(tid + 8) * sn : nv(tid) * cs + nv(tid - 8) * sn; }
      const float kv = bf2f(dqkv[(size_t)r * 1536 + hd * 64 + tid]);
      if (hd >= 16) o = raw[tid];
      err = fmaxf(err, fabsf(o - kv)); mag = fmaxf(mag, fabsf(o));
    }
  }
  const float E = blk_max(err, red, tid), G = blk_max(mag, red, tid);
  if (tid == 0) ((float*)(p->ws + OFF_SCAL))[8] = 1000.f + 1000.f * fminf(E / G, 50.f);
}
#endif
#define EPI_WRAP(name, f) auto name = [=](const f32x4 (&acc)[2][2][4][2], int pm, int pn, int wr, int wc, int fr, int fq) { epi_each(acc, pm, pn, wr, wc, fr, fq, f); }
__global__ void __launch_bounds__(512) mega(Pm p_unused) {
  PmK p = (PmK)__builtin_amdgcn_kernarg_segment_ptr();
  extern __shared__ __attribute__((aligned(16))) char lds[];
  cg::grid_group grid = cg::this_grid();
  const int lo = p->ph0, hi = p->ph1;
#define IN(k) ((ONLY < 0 || ONLY == (k)) && lo <= l * NPH + (k) && l * NPH + (k) < hi)
#define SEAM(k) do { if (l * NPH + (k) + 1 < hi) grid.sync(); } while (0)
  for (int l = 0; l < 2; ++l) {
    if (IN(0)) { LAUNDER(p); char* const ws = p->ws; (void)ws; phase_prep(p, l, lds); if (DUP & 8) phase_prep(p, l, lds); SEAM(0); }
    if (IN(1)) { LAUNDER(p); char* const ws = p->ws; (void)ws;
      bf16_t* pa = (bf16_t*)(ws + OFF_PA); bf16_t* dqkv = (bf16_t*)(ws + OFF_DQKV);
      auto f = [=](int row, int col, f32x4 v) {
        if (col < 672) st_bf4(pa + (size_t)row * 672 + col, v);
        else if (col < 2208) st_bf4(dqkv + (size_t)row * 1536 + (col - 672), v);
      };
      EPI_WRAP(epi, f);
      gemm_simple(lds, (const bf16_t*)(ws + OFF_HN), 1024, (const bf16_t*)(ws + OFF_WIN), 1024, R / 256, XW / 256, 1024, epi);
      if (DUP & 1) gemm_simple(lds, (const bf16_t*)(ws + OFF_HN), 1024, (const bf16_t*)(ws + OFF_WIN), 1024, R / 256, XW / 256, 1024, epi);
      SEAM(1);
    }
    if (IN(2)) { LAUNDER(p); char* const ws = p->ws; (void)ws;
      bf16_t* mq = (bf16_t*)(ws + OFF_MQ); bf16_t* knr = (bf16_t*)(ws + OFF_KNR); bf16_t* mv = (bf16_t*)(ws + OFF_MVR);
      auto fq_ = [=](int row, int col, f32x4 v) { st_bf4(mq + (size_t)row * 768 + col, v); };
      EPI_WRAP(epiq, fq_);
      gemm_simple(lds, (const bf16_t*)(ws + OFF_PA), 672, (const bf16_t*)(ws + OFF_WUQ), 384, R / 256, 3, 384, epiq);
      auto fkv = [=](int row, int col, f32x4 v) {
        const int hh = col >> 7, c = col & 127;
        if (c < 64) st_bf4(knr + (size_t)row * 512 + hh * 64 + c, v); else st_bf4(mv + (size_t)row * 512 + hh * 64 + (c - 64), v);
      };
      EPI_WRAP(epikv, fkv);
      gemm_simple(lds, (const bf16_t*)(ws + OFF_PA) + 384, 672, (const bf16_t*)(ws + OFF_WUKV), 256, R / 256, 4, 256, epikv);
      SEAM(2);
    }
    if (IN(3)) { LAUNDER(p); char* const ws = p->ws; (void)ws; phase_p3(p, l, lds); phase_p2x(p, l); vtrans_items(p, lds); SEAM(3); }
    if (IN(4)) { LAUNDER(p); char* const ws = p->ws; (void)ws; phase_attn(p, lds); SEAM(4); }
    if (IN(5)) { LAUNDER(p); char* const ws = p->ws; (void)ws;
      bf16_t* sz = (bf16_t*)(ws + OFF_SZ); bf16_t* xr = (bf16_t*)(ws + OFF_XBCR); bf16_t* mo = (bf16_t*)(ws + OFF_MQKVO); float* gates = (float*)(ws + OFF_GATES);
      auto f = [=](int row, int col, f32x4 v) {
        if (col < 512) st_bf4(sz + (size_t)row * 512 + col, v);
        else if (col < 1280) st_bf4(xr + (size_t)row * 768 + (col - 512), v);
        else if (col < 2816) st_bf4(mo + (size_t)row * 1536 + (col - 1280), v);
        else if (col < 2848) *(f32x4*)(gates + (size_t)row * 32 + (col - 2816)) = v;
      };
      EPI_WRAP(epi, f);
      gemm_simple(lds, (const bf16_t*)(ws + OFF_HN), 1024, (const bf16_t*)(ws + OFF_WIN) + (size_t)XW * 1024, 1024, R / 256, YW / 256, 1024, epi);
      if (DUP & 1) gemm_simple(lds, (const bf16_t*)(ws + OFF_HN), 1024, (const bf16_t*)(ws + OFF_WIN) + (size_t)XW * 1024, 1024, R / 256, YW / 256, 1024, epi);
      SEAM(5);
    }
    if (IN(6)) { LAUNDER(p); char* const ws = p->ws; (void)ws; phase_p2y(p, l); SEAM(6); }
    if (IN(7)) { LAUNDER(p); char* const ws = p->ws; (void)ws; phase_states(p, l, lds); if (DUP & 4) phase_states(p, l, lds); SEAM(7); }
    if (IN(8)) { LAUNDER(p); char* const ws = p->ws; (void)ws; phase_scan(p); SEAM(8); }
    if (IN(9)) { LAUNDER(p); char* const ws = p->ws; (void)ws; phase_out(p, l, lds); if (DUP & 4) phase_out(p, l, lds); SEAM(9); }
    if (IN(10)) { LAUNDER(p); char* const ws = p->ws; (void)ws; phase_post(p, l); SEAM(10); }
    if (IN(11)) { LAUNDER(p); char* const ws = p->ws; (void)ws;
      float* const outp = p->out; float* const metah = (float*)(ws + OFF_METAH);
      auto f = [=](int row, int col, f32x4 v) { float* hr = hrow2(outp, metah, row); if (hr) { f32x4* d = (f32x4*)(hr + col); *d = *d + v; } };
      EPI_WRAP(epi, f);
      gemm_simple(lds, (const bf16_t*)(ws + OFF_MIXED), 2048, (const bf16_t*)(ws + OFF_WOUT), 2048, R / 256, 4, 2048, epi);
      SEAM(11);
    }
    if (IN(12)) { LAUNDER(p); char* const ws = p->ws; (void)ws; norm_rows(p, false); SEAM(12); }
    if (IN(13)) { LAUNDER(p); char* const ws = p->ws; (void)ws;
      bf16_t* act = (bf16_t*)(ws + OFF_ACT);
      auto epi = [=](const f32x4 (&acc)[2][2][4][2], int pm, int pn, int wr, int wc, int fr, int fq) {
#pragma unroll
        for (int ai = 0; ai < 2; ++ai)
#pragma unroll
          for (int m = 0; m < 4; ++m) {
            const int row = pm * 256 + 128 * ai + 64 * wr + 16 * m + fr;
#pragma unroll
            for (int n = 0; n < 2; ++n) {
              const f32x4 g = acc[ai][0][m][n], u = acc[ai][1][m][n];
              f32x4 a; a[0] = siluf(g[0]) * u[0]; a[1] = siluf(g[1]) * u[1]; a[2] = siluf(g[2]) * u[2]; a[3] = siluf(g[3]) * u[3];
              st_bf4(act + (size_t)row * 2816 + pn * 128 + 32 * wc + 16 * n + 4 * fq, a);
            }
          }
      };
      gemm_simple(lds, (const bf16_t*)(ws + OFF_HN), 1024, (const bf16_t*)(ws + OFF_WFI), 1024, R / 256, 22, 1024, epi);
      if (DUP & 1) gemm_simple(lds, (const bf16_t*)(ws + OFF_HN), 1024, (const bf16_t*)(ws + OFF_WFI), 1024, R / 256, 22, 1024, epi);
      SEAM(13);
    }
    if (IN(14)) { LAUNDER(p); char* const ws = p->ws; (void)ws;
      float* const outp = p->out; float* const metah = (float*)(ws + OFF_METAH);
      auto f = [=](int row, int col, f32x4 v) { float* hr = hrow2(outp, metah, row); if (hr) { f32x4* d = (f32x4*)(hr + col); *d = *d + v; } };
      EPI_WRAP(epi, f);
      gemm_simple(lds, (const bf16_t*)(ws + OFF_ACT), 2816, (const bf16_t*)(ws + OFF_WFO), 2816, R / 256, 4, 2816, epi);
      SEAM(14);
    }
  }
#undef IN
#undef SEAM
#if DBGCHK
  grid.sync();
  if (blockIdx.x == 0) dbg_check_p2x(p, 0, lds);
  grid.sync();
  { float* o = p->out; const float code = ((const float*)(p->ws + OFF_SCAL))[8];
    for (size_t i = (size_t)blockIdx.x * 512 + threadIdx.x; i < (size_t)4 * 8192 * 1024; i += (size_t)gridDim.x * 512) o[i] = i == 0 ? code : 0.f; }
#endif
}

__global__ void __launch_bounds__(512) dbg_hash(const unsigned* ws, size_t nwords, float* out) {
  const size_t gt = (size_t)blockIdx.x * 512 + threadIdx.x, gn = (size_t)gridDim.x * 512;
  unsigned h = 0;
  for (size_t i = gt; i < nwords; i += gn) h = h * 31u + ws[i];
  out[gt] = (float)(h & 0xFFFFFu);
}
constexpr size_t LDS_BYTES = 140 * 1024;
extern "C" void kernel_launch(void* const* d_in, const int* in_sizes, int n_in, void* d_out, int out_size, void* d_ws, size_t ws_size, hipStream_t stream) {
  static int grid_blocks = 0;
  if (!grid_blocks) {
    if (ws_size < WS_NEED) { fprintf(stderr, "kernel_launch: workspace too small: %zu < %zu\n", ws_size, WS_NEED); return; }
    if (hipFuncSetAttribute((const void*)mega, hipFuncAttributeMaxDynamicSharedMemorySize, (int)LDS_BYTES) != hipSuccess) { fprintf(stderr, "kernel_launch: LDS attribute failed\n"); return; }
    int dev = 0, cus = 0, per_cu = 0;
    hipGetDevice(&dev);
    hipDeviceGetAttribute(&cus, hipDeviceAttributeMultiprocessorCount, dev);
    hipOccupancyMaxActiveBlocksPerMultiprocessor(&per_cu, mega, 512, LDS_BYTES);
    if (per_cu < 1) { fprintf(stderr, "kernel_launch: occupancy 0\n"); return; }
    grid_blocks = cus * 1;
  }
  Pm p;
  memset(&p, 0, sizeof(p));
  const float** fp = (const float**)&p;
  for (int i = 0; i < 28; ++i) fp[i] = (const float*)d_in[i];
  p.out = (float*)d_out; p.ws = (char*)d_ws;
  for (int i = 0; i < 16; ++i) p.inv_m[i] = 1.0f / powf(500000.0f, (float)(2 * i) / 32.0f);
  for (int i = 0; i < 8; ++i) p.inv_d[i] = 1.0f / powf(500000.0f, (float)(2 * i) / 16.0f);
  for (int l = 0; l < 2; ++l) p.linit[l] = (float)(0.8 - 0.6 * exp(-0.3 * l));
#if MULTI
  for (int ph = 0; ph < DBG_NPH; ++ph) {
    p.ph0 = ph; p.ph1 = ph + 1;
    hipLaunchKernelGGL(mega, dim3(grid_blocks), dim3(512), LDS_BYTES, stream, p);
  }
#else
  p.ph0 = 0; p.ph1 = DBGCHK ? 5 : 2 * NPH;
  void* args[] = {&p};
  hipError_t e = hipLaunchCooperativeKernel((void*)mega, dim3(grid_blocks), dim3(512), args, LDS_BYTES, stream);
  if (e != hipSuccess) fprintf(stderr, "cooperative launch failed: %s (grid %d)\n", hipGetErrorString(e), grid_blocks);
#endif
}
```

```cpp
#include <hip/hip_runtime.h>
#include <hip/hip_cooperative_groups.h>
#include <cstdio>
#include <cmath>
#include <cstring>
namespace cg = cooperative_groups;

typedef unsigned short bf16_t;
typedef short bf16x8 __attribute__((ext_vector_type(8)));
typedef float f32x4 __attribute__((ext_vector_type(4)));
typedef unsigned u32x4 __attribute__((ext_vector_type(4)));
#define DI __device__ __forceinline__
#define MFMA16(a, b, c) __builtin_amdgcn_mfma_f32_16x16x32_bf16((a), (b), (c), 0, 0, 0)

#ifndef MULTI
#define MULTI 0
#endif
#ifndef DBG_NPH
#define DBG_NPH (2 * NPH)
#endif
#ifndef ZB
#define ZB -1
#endif
#ifndef DUP
#define DUP 0
#endif
#ifndef ONLY
#define ONLY -1
#endif

constexpr int NB = 4, TP = 8320, R = NB * TP, NCH = 65, PAD0 = 112;
constexpr int XW = 2304, YW = 3072;
constexpr int NPH = 15;
constexpr float NEGF = -1e30f;
constexpr float LOG2E = 1.4426950408889634f;

constexpr size_t al256(size_t x) { return (x + 255) & ~size_t(255); }
constexpr size_t SZ_WIN = (size_t)(XW + YW) * 1024 * 2, SZ_WUQ = (size_t)768 * 384 * 2, SZ_WUKV = (size_t)1024 * 256 * 2,
                 SZ_WOUT = (size_t)1024 * 2048 * 2, SZ_WFI = (size_t)5632 * 1024 * 2, SZ_WFO = (size_t)1024 * 2816 * 2;
constexpr size_t OFF_WIN = 0, OFF_WUQ = OFF_WIN + al256(SZ_WIN), OFF_WUKV = OFF_WUQ + al256(SZ_WUQ), OFF_WOUT = OFF_WUKV + al256(SZ_WUKV),
                 OFF_WFI = OFF_WOUT + al256(SZ_WOUT), OFF_WFO = OFF_WFI + al256(SZ_WFI), OFF_METAH = OFF_WFO + al256(SZ_WFO),
                 OFF_SCAL = OFF_METAH + al256((size_t)64 * 1024 * 4), OFF_SSDD = OFF_SCAL + 256,
                 OFF_MLG = OFF_SSDD + al256((size_t)64 * NCH * 4), OFF_BAR = OFF_MLG + al256((size_t)32 * NCH * 3 * 4), OFF_HN = OFF_BAR + 16384;
constexpr size_t SZ_HN = (size_t)R * 1024 * 2;
constexpr size_t OFF_SSDS = OFF_HN;
constexpr size_t OFF_MIXED = OFF_HN + al256(SZ_HN);
constexpr size_t SZ_MIXED = (size_t)R * 2048 * 2;
constexpr size_t OFF_PA = OFF_MIXED, OFF_KNR = OFF_PA + al256((size_t)R * 672 * 2), OFF_MVR = OFF_KNR + al256((size_t)R * 512 * 2);
constexpr size_t OFF_U = OFF_MIXED + al256(SZ_MIXED);
constexpr size_t OFF_DQKV = OFF_U, OFF_MQ = OFF_DQKV + al256((size_t)R * 1536 * 2), OFF_MK = OFF_MQ + al256((size_t)R * 768 * 2),
                 OFF_MVT = OFF_MK + al256((size_t)R * 768 * 2), OFF_DVT = OFF_MVT + al256((size_t)R * 512 * 2), END_X = OFF_DVT + al256((size_t)R * 512 * 2);
constexpr size_t OFF_SZ = OFF_U, OFF_XBCC = OFF_SZ + al256((size_t)R * 512 * 2), OFF_MQKVO = OFF_XBCC + al256((size_t)R * 768 * 2),
                 OFF_GATES = OFF_MQKVO + al256((size_t)R * 1536 * 2), OFF_MLS = OFF_GATES + al256((size_t)R * 32 * 4),
                 END_Y = OFF_MLS + al256((size_t)32 * NCH * 9216 * 4);
constexpr size_t OFF_XBCR = OFF_MLS;
constexpr size_t OFF_ACT = OFF_U, END_F = OFF_ACT + al256((size_t)R * 2816 * 2);
constexpr size_t WS_NEED = (END_X > END_Y ? (END_X > END_F ? END_X : END_F) : (END_Y > END_F ? END_Y : END_F));
static_assert(SZ_HN == (size_t)64 * NCH * 4096 * 4, "ssd states alias hn");
static_assert(OFF_MVR + (size_t)R * 512 * 2 <= OFF_U, "transients fit in mixed");
static_assert((size_t)R * 768 * 2 <= (size_t)32 * NCH * 9216 * 4, "xbc raw fits in mlstm states");

struct Pm {
  const float *x, *meta, *attn_g, *w_in, *q_norm_g, *kv_norm_g, *w_uq, *w_ukv, *q_head_g, *k_head_g, *mla_out_g, *conv_w, *conv_b,
      *dt_bias, *a_log, *ssd_d, *ssd_norm_g, *dq_g, *dk_g, *dlam, *dout_g, *i_bias, *f_bias, *ml_out_g, *w_out, *ffn_g, *w_fi, *w_fo;
  float* out;
  char* ws;
  float inv_m[16];
  float inv_d[8];
  float linit[2];
  int ph0, ph1;
};

typedef const Pm __attribute__((address_space(4)))* PmK;
#define LAUNDER(p) asm volatile("" : "+s"(p))
extern __shared__ __attribute__((aligned(16))) char g_lds[];
constexpr int WID_TAB_OFF = 139 * 1024;
DI int otid() {
  const int key = __builtin_amdgcn_s_getreg(10244) & 63;
  const int wv = __builtin_amdgcn_readfirstlane(((volatile int*)(g_lds + WID_TAB_OFF))[key]);
  unsigned ones = ~0u; asm volatile("" : "+s"(ones));
  int t = wv * 64 + (int)__builtin_amdgcn_mbcnt_hi(ones, __builtin_amdgcn_mbcnt_lo(ones, 0u));
  asm volatile("" : "+v"(t));
  return t;
}
typedef __bf16 bf2_t __attribute__((ext_vector_type(2)));
typedef float f32x2 __attribute__((ext_vector_type(2)));
DI unsigned cvt_pk(float lo, float hi) { f32x2 v = {lo, hi}; bf2_t b = __builtin_convertvector(v, bf2_t); return __builtin_bit_cast(unsigned, b); }
DI bf16_t f2bf(float x) { return (bf16_t)(cvt_pk(x, 0.f) & 0xffffu); }
DI float bf2f(bf16_t b) { return __uint_as_float(((unsigned)b) << 16); }
DI float bflo(unsigned w) { return __uint_as_float(w << 16); }
DI float bfhi(unsigned w) { return __uint_as_float(w & 0xffff0000u); }
DI void st_bf4(bf16_t* dst, f32x4 v) { uint2 w; w.x = cvt_pk(v[0], v[1]); w.y = cvt_pk(v[2], v[3]); *(uint2*)dst = w; }
DI f32x4 ld_bf4(const bf16_t* src) { uint2 w = *(const uint2*)src; f32x4 v; v[0] = bflo(w.x); v[1] = bfhi(w.x); v[2] = bflo(w.y); v[3] = bfhi(w.y); return v; }
DI void ld_bf8(const bf16_t* src, float* v) { uint4 w = *(const uint4*)src; v[0] = bflo(w.x); v[1] = bfhi(w.x); v[2] = bflo(w.y); v[3] = bfhi(w.y); v[4] = bflo(w.z); v[5] = bfhi(w.z); v[6] = bflo(w.w); v[7] = bfhi(w.w); }
DI void st_bf8(bf16_t* dst, const float* v) { uint4 w; w.x = cvt_pk(v[0], v[1]); w.y = cvt_pk(v[2], v[3]); w.z = cvt_pk(v[4], v[5]); w.w = cvt_pk(v[6], v[7]); *(uint4*)dst = w; }
DI float wsum(float v) { for (int m = 32; m >= 1; m >>= 1) v += __shfl_xor(v, m); return v; }
DI float wmax(float v) { for (int m = 32; m >= 1; m >>= 1) v = fmaxf(v, __shfl_xor(v, m)); return v; }
DI float fexp(float x) { return __builtin_amdgcn_exp2f(x * LOG2E); }
DI float siluf(float x) { return x * __builtin_amdgcn_rcpf(1.f + fexp(-x)); }
DI float sigmf(float x) { return __builtin_amdgcn_rcpf(1.f + fexp(-x)); }
DI float softplusf(float x) { const float e = fexp(x); return x > 20.f ? x : (x < -4.f ? e * (1.f - 0.5f * e + 0.33333334f * e * e) : 0.6931471805599453f * __builtin_amdgcn_logf(1.f + e)); }
DI float* hrow2(float* out, float* metah, int r) {
  const int b = r / TP, pp = r - b * TP;
  if (pp < PAD0) return nullptr;
  if (pp < 128) return metah + (size_t)(b * 16 + pp - PAD0) * 1024;
  return out + ((size_t)b * 8192 + pp - 128) * 1024;
}
DI float* hrow(PmK p, int r) { return hrow2(p->out, (float*)(p->ws + OFF_METAH), r); }
DI void sincos_rev(float ang, float& c, float& s) {
  double rev = (double)ang * 0.15915494309189535; rev -= rint(rev); const float f = (float)rev;
  s = __builtin_amdgcn_sinf(f); c = __builtin_amdgcn_cosf(f);
}
DI f32x4 mma_lds(const bf16_t* X, int ldx, const bf16_t* Y, int ldy, int K, f32x4 acc, int fr, int fq) {
  for (int k0 = 0; k0 < K; k0 += 32) {
    const bf16x8 x = *(const bf16x8*)(X + fr * ldx + k0 + fq * 8), y = *(const bf16x8*)(Y + fr * ldy + k0 + fq * 8);
    acc = MFMA16(x, y, acc);
  }
  __builtin_amdgcn_sched_barrier(0);
  return acc;
}
DI void scan128_sum(const float* v, float* cum, int dir, int lane) {
  const int i0 = 2 * lane, n0 = dir ? 127 - i0 : i0, n1 = dir ? 126 - i0 : i0 + 1;
  const float a = v[n0], b = a + v[n1]; float s = b;
  for (int d = 1; d < 64; d <<= 1) { const float t = __shfl_up(s, d); if (lane >= d) s += t; }
  const float ex = s - b; cum[n0] = ex + a; cum[n1] = ex + b;
}
DI void scan128_max(const float* v, float* cum, int dir, int lane) {
  const int i0 = 2 * lane, n0 = dir ? 127 - i0 : i0, n1 = dir ? 126 - i0 : i0 + 1;
  const float a = v[n0], b = fmaxf(a, v[n1]); float s = b;
  for (int d = 1; d < 64; d <<= 1) { const float t = __shfl_up(s, d); if (lane >= d) s = fmaxf(s, t); }
  float ex = __shfl_up(s, 1); if (lane == 0) ex = NEGF * 3.f;
  cum[n0] = fmaxf(ex, a); cum[n1] = fmaxf(ex, b);
}

#define XB_TMO      128
#define XB_XCNT(j)  (256  + 64 * (j))
#define XB_XSUB(j)  (1280 + 64 * (j))
#define XB_XGEN(j)  (2304 + 64 * (j))
#define XB_TOP      3328
#define XB_TOPGEN   3392
#define XCD_BAR_WORDS 3456
#define XB_SPIN_CAP (1u << 18)
#define LAS __attribute__((address_space(3)))

__device__ __forceinline__ unsigned xb_ld(unsigned* p)              { return __hip_atomic_load(p, __ATOMIC_RELAXED, __HIP_MEMORY_SCOPE_AGENT); }
__device__ __forceinline__ unsigned xb_add(unsigned* p, unsigned v) { return __hip_atomic_fetch_add(p, v, __ATOMIC_RELAXED, __HIP_MEMORY_SCOPE_AGENT); }
__device__ __forceinline__ unsigned xb_xcc_id() { return (unsigned)__builtin_amdgcn_s_getreg((3 << 11) | 20) & 0xFu; }
#define XB_SPIN(cond, bar) do { unsigned _sp = 0; while (cond) { __builtin_amdgcn_s_sleep(1); \
    if ((++_sp & 255u) == 0u) { if (xb_ld(&(bar)[XB_TMO])) break; if (_sp > XB_SPIN_CAP) { atomicAdd(&(bar)[XB_TMO], 1u); break; } } } } while (0)

struct XcdBarrier {
    unsigned* bar; unsigned x;
    volatile LAS unsigned* st;
};

__device__ __forceinline__ XcdBarrier xcd_barrier_post(unsigned* bar, volatile LAS unsigned* st, bool xb_tid0) {
    XcdBarrier b; b.bar = bar; b.x = xb_xcc_id(); b.st = st;
    if (xb_tid0) (void)xb_add(&bar[XB_XCNT(b.x)], 1u);
    return b;
}
__device__ __forceinline__ void xcd_barrier_complete(unsigned* bar, unsigned x, unsigned& nloc, unsigned& nx) {
    const unsigned G = gridDim.x * gridDim.y * gridDim.z;
    unsigned sum, cnt, mine, sp = 0u;
    for (;;) {
        sum = 0u; cnt = 0u; mine = 0u;
#pragma unroll
        for (unsigned j = 0; j < 16; ++j) { const unsigned c = xb_ld(&bar[XB_XCNT(j)]); sum += c; cnt += (c > 0u) ? 1u : 0u; mine = (j == x) ? c : mine; }
        if (sum == G) break;
        __builtin_amdgcn_s_sleep(1);
        if ((++sp & 255u) == 0u) { if (xb_ld(&bar[XB_TMO])) break; if (sp > XB_SPIN_CAP) { atomicAdd(&bar[XB_TMO], 1u); break; } }
    }
    nloc = mine > 0u ? mine : 1u; nx = cnt > 0u ? cnt : 1u;
}

__device__ __forceinline__ void xcd_barrier(const XcdBarrier& b) {
    const bool xb_tid0 = otid() == 0;
    asm volatile("s_waitcnt vmcnt(0)" ::: "memory");
    __syncthreads();
    if (xb_tid0) {
        unsigned* bar = b.bar;
        __builtin_amdgcn_s_waitcnt(0);
        unsigned nloc = b.st[0], nx = b.st[1];
        if (nloc == 0u) { xcd_barrier_complete(bar, b.x, nloc, nx); b.st[0] = nloc; b.st[1] = nx; }
        const unsigned old = xb_add(&bar[XB_XSUB(b.x)], 1u);
        const unsigned gen = old / nloc;
        if (old + 1u == (gen + 1u) * nloc) {
            __builtin_amdgcn_fence(__ATOMIC_RELEASE, "agent");
            asm volatile("s_waitcnt vmcnt(0)" ::: "memory");
            const unsigned og = xb_add(&bar[XB_TOP], 1u);
            const unsigned tg = og / nx;
            if (og + 1u == (tg + 1u) * nx) xb_add(&bar[XB_TOPGEN], 1u);
            else XB_SPIN(xb_ld(&bar[XB_TOPGEN]) == tg, bar);
            __builtin_amdgcn_fence(__ATOMIC_ACQUIRE, "agent");
            xb_add(&bar[XB_XGEN(b.x)], 1u);
            asm volatile("s_waitcnt vmcnt(0)" ::: "memory");
        } else {
            XB_SPIN(xb_ld(&bar[XB_XGEN(b.x)]) == gen, bar);
            __builtin_amdgcn_fence(__ATOMIC_ACQUIRE, "agent");
            asm volatile("s_waitcnt vmcnt(0)" ::: "memory");
        }
    }
    __syncthreads();
}


DI void seam_barrier(PmK p) {
  LAUNDER(p);
  XcdBarrier b; b.bar = (unsigned*)(p->ws + OFF_BAR); b.x = xb_xcc_id(); b.st = (volatile LAS unsigned*)(g_lds + WID_TAB_OFF + 512);
  xcd_barrier(b);
}

DI int map_in(int n) {
  if (n < 672) return n;
  if (n < 1184) return XW + (n - 672);
  if (n < 1952) return XW + 512 + (n - 1184);
  if (n < 1968) return XW + 2816 + (n - 1952);
  if (n < 3504) return 672 + (n - 1968);
  if (n < 5040) return XW + 1280 + (n - 3504);
  return XW + 2832 + (n - 5040);
}
DI int map_fi(int n) { const int half = n >= 2816, j = n - half * 2816; return 256 * (j >> 7) + half * 128 + (j & 127); }
template <int MODE>
DI void wtrans(char* lds, const float* __restrict__ W, int K, int N, const float* __restrict__ g, bf16_t* __restrict__ Wt) {
  float* tl = (float*)lds;
  const int tid = otid(), nkt = K / 64, nnt = N / 64;
  for (int t = blockIdx.x; t < nkt * nnt; t += gridDim.x) {
    const int kt = t % nkt, nt = t / nkt;
    __syncthreads();
#pragma unroll
    for (int i = 0; i < 8; ++i) {
      const int k = (tid >> 6) + 8 * i, n = tid & 63;
      float v = W[(size_t)(kt * 64 + k) * N + nt * 64 + n];
      if (g) v *= g[kt * 64 + k];
      tl[k * 65 + n] = v;
    }
    __syncthreads();
#pragma unroll
    for (int i = 0; i < 8; ++i) {
      const int n = (tid >> 6) + 8 * i, k = tid & 63, gn = nt * 64 + n;
      const int dst = MODE == 1 ? map_in(gn) : MODE == 2 ? map_fi(gn) : gn;
      Wt[(size_t)dst * K + kt * 64 + k] = f2bf(tl[k * 65 + n]);
    }
  }
}

DI void norm_rows(PmK p, bool first) {
  LAUNDER(p);
  const int tid_ = otid(), wid = tid_ >> 6, lane = tid_ & 63;
  bf16_t* hn = (bf16_t*)(p->ws + OFF_HN);
  for (int r = blockIdx.x * 8 + wid; r < R; r += gridDim.x * 8) {
    const int b = r / TP, pp = r - b * TP;
    bf16_t* dst = hn + (size_t)r * 1024;
    if (pp < PAD0) {
      unsigned zz = 0u; asm volatile("" : "+v"(zz)); const uint4 z = {zz, zz, zz, zz};
      *(uint4*)(dst + lane * 16) = z; *(uint4*)(dst + lane * 16 + 8) = z;
      continue;
    }
    float* hr = hrow(p, r);
    const float* src = first ? (pp < 128 ? p->meta + (size_t)(pp - PAD0) * 1024 : p->x + ((size_t)b * 8192 + pp - 128) * 1024) : hr;
    f32x4 v[4]; float ss = 0.f;
#pragma unroll
    for (int i = 0; i < 4; ++i) { v[i] = *(const f32x4*)(src + i * 256 + lane * 4); ss += v[i][0] * v[i][0] + v[i][1] * v[i][1] + v[i][2] * v[i][2] + v[i][3] * v[i][3]; }
    ss = wsum(ss);
    const float rinv = rsqrtf(ss * (1.f / 1024.f) + 1e-6f);
#pragma unroll
    for (int i = 0; i < 4; ++i) {
      if (first) *(f32x4*)(hr + i * 256 + lane * 4) = v[i];
      st_bf4(dst + i * 256 + lane * 4, v[i] * rinv);
    }
  }
}

DI void phase_prep(PmK p, int l, char* lds) {
  LAUNDER(p);
  char* ws = p->ws;
  wtrans<1>(lds, p->w_in + (size_t)l * 1024 * 5056, 1024, 5056, p->attn_g + l * 1024, (bf16_t*)(ws + OFF_WIN));
  wtrans<0>(lds, p->w_uq + (size_t)l * 384 * 768, 384, 768, p->q_norm_g + l * 384, (bf16_t*)(ws + OFF_WUQ));
  wtrans<0>(lds, p->w_ukv + (size_t)l * 256 * 1024, 256, 1024, p->kv_norm_g + l * 256, (bf16_t*)(ws + OFF_WUKV));
  wtrans<0>(lds, p->w_out + (size_t)l * 2048 * 1024, 2048, 1024, nullptr, (bf16_t*)(ws + OFF_WOUT));
  wtrans<2>(lds, p->w_fi + (size_t)l * 1024 * 5632, 1024, 5632, p->ffn_g + l * 1024, (bf16_t*)(ws + OFF_WFI));
  wtrans<0>(lds, p->w_fo + (size_t)l * 2816 * 1024, 2816, 1024, nullptr, (bf16_t*)(ws + OFF_WFO));
  bf16_t* win = (bf16_t*)(ws + OFF_WIN);
  const int tidp = otid();
  for (int i = blockIdx.x * 512 + tidp; i < (96 + 224) * 1024; i += gridDim.x * 512) {
    const int row = i >> 10, k = i & 1023;
    const int dst = row < 96 ? 2208 + row : XW + 2848 + (row - 96);
    win[(size_t)dst * 1024 + k] = 0;
  }
  if (blockIdx.x == 0 && tidp < 64) {
    const float* lam = p->dlam + l * 256; const int t = tidp;
    const float s1 = wsum(lam[t] * lam[64 + t]), s2 = wsum(lam[128 + t] * lam[192 + t]);
    if (t == 0) { float* sc = (float*)(p->ws + OFF_SCAL); asm volatile("" : "+s"(sc)); sc[0] = expf(s1) - expf(s2) + p->linit[l]; int z0 = 0; asm volatile("" : "+v"(z0)); ((int*)sc)[16] = z0; ((int*)sc)[17] = z0; ((int*)sc)[18] = z0; ((int*)sc)[19] = z0; }
  }
  norm_rows(p, l == 0);
}

template <class Epi>
DI void gemm_simple(char* lds, const bf16_t* __restrict__ A, int lda, const bf16_t* __restrict__ Bt, int ldb, int nM, int nN, int K, const Epi& epi) {
  const int tid = otid(), wid = tid >> 6, lane = tid & 63, wr = wid >> 2, wc = wid & 3, fr = lane & 15, fq = lane >> 4;
  bf16_t* As = (bf16_t*)lds; bf16_t* Bs = As + 256 * 72;
  for (int tile = blockIdx.x; tile < nM * nN; tile += gridDim.x) {
    const int pm = tile / nN, pn = tile - pm * nN;
    f32x4 acc[2][2][4][2];
#pragma unroll
    for (int a = 0; a < 2; ++a)
#pragma unroll
      for (int b = 0; b < 2; ++b)
#pragma unroll
        for (int m = 0; m < 4; ++m)
#pragma unroll
          for (int n = 0; n < 2; ++n) acc[a][b][m][n] = (f32x4){0.f, 0.f, 0.f, 0.f};
    const bf16_t* Ab = A + (size_t)pm * 256 * lda + (size_t)(tid >> 3) * lda + (tid & 7) * 8;
    const bf16_t* Bb = Bt + (size_t)pn * 256 * ldb + (size_t)(tid >> 3) * ldb + (tid & 7) * 8;
    bf16_t* const Asw = As + (tid >> 3) * 72 + (tid & 7) * 8; bf16_t* const Bsw = Bs + (tid >> 3) * 72 + (tid & 7) * 8;
    bf16x8 ra[4], rb[4];
#pragma unroll
    for (int i = 0; i < 4; ++i) { ra[i] = *(const bf16x8*)(Ab + (size_t)i * 64 * lda); rb[i] = *(const bf16x8*)(Bb + (size_t)i * 64 * ldb); }
#pragma unroll 1
    for (int k0 = 0; k0 < K; k0 += 64) {
      __syncthreads();
#pragma unroll
      for (int i = 0; i < 4; ++i) { *(bf16x8*)(Asw + i * 64 * 72) = ra[i]; *(bf16x8*)(Bsw + i * 64 * 72) = rb[i]; }
      __syncthreads();
      if (k0 + 64 < K) {
        Ab += 64; Bb += 64;
#pragma unroll
        for (int i = 0; i < 4; ++i) { ra[i] = *(const bf16x8*)(Ab + (size_t)i * 64 * lda); rb[i] = *(const bf16x8*)(Bb + (size_t)i * 64 * ldb); }
      }
#pragma unroll
      for (int ks = 0; ks < 2; ++ks) {
        bf16x8 bfr[2][2];
#pragma unroll
        for (int bj = 0; bj < 2; ++bj)
#pragma unroll
          for (int n = 0; n < 2; ++n) bfr[bj][n] = *(const bf16x8*)(Bs + (128 * bj + 32 * wc + 16 * n + fr) * 72 + ks * 32 + fq * 8);
#pragma unroll
        for (int ai = 0; ai < 2; ++ai) {
          bf16x8 af[4];
#pragma unroll
          for (int m = 0; m < 4; ++m) af[m] = *(const bf16x8*)(As + (128 * ai + 64 * wr + 16 * m + fr) * 72 + ks * 32 + fq * 8);
#pragma unroll
          for (int bj = 0; bj < 2; ++bj)
#pragma unroll
            for (int m = 0; m < 4; ++m)
#pragma unroll
              for (int n = 0; n < 2; ++n) acc[ai][bj][m][n] = MFMA16(bfr[bj][n], af[m], acc[ai][bj][m][n]);
        }
      }
    }
    epi(acc, pm, pn, wr, wc, fr, fq);
  }
  __syncthreads();
}
template <class F>
DI void epi_each(const f32x4 (&acc)[2][2][4][2], int pm, int pn, int wr, int wc, int fr, int fq, const F& f) {
#pragma unroll
  for (int ai = 0; ai < 2; ++ai)
#pragma unroll
    for (int m = 0; m < 4; ++m) {
      const int row = pm * 256 + 128 * ai + 64 * wr + 16 * m + fr;
#pragma unroll
      for (int bj = 0; bj < 2; ++bj)
#pragma unroll
        for (int n = 0; n < 2; ++n) f(row, pn * 256 + 128 * bj + 32 * wc + 16 * n + 4 * fq, acc[ai][bj][m][n]);
    }
}

namespace pg8 {
#define PG8_LAS __attribute__((address_space(3)))
constexpr int BM = 256, BK = 64, HALF = 128, HTB = HALF * BK * 2  , STAGE_BYTES = 8 * HTB, NXCD = 8, WGM = 8;

__host__ __device__ __forceinline__ int lds_byte(int r, int c) { const int st = (r >> 4) * 2 + (c >> 5), rr = r & 15, cc = c & 31, ob = rr * 64 + cc * 2; return st * 1024 + (ob ^ (((ob >> 9) & 1) << 5)); }
__host__ __device__ __forceinline__ void stage_rc(int b, int& R, int& C) { const int st = b / 1024, sb = b % 1024, swz = sb ^ (((sb >> 9) & 1) << 5); R = (st >> 1) * 16 + swz / 64; C = (st & 1) * 32 + (swz % 64) / 2; }
__host__ __device__ __forceinline__ int perm32(int rho) { const int n = rho >> 4, i = rho & 15; return 8 * (i >> 2) + 4 * n + (i & 3); }

struct Unit { int pm, pn; };
struct Gemm { const bf16_t* A; const bf16_t* Bt; int lda, ldb, K; };
struct RowOrder {
    int nN, n, G, c;
    __device__ bool next(int i, Unit& u) const {
        const int x = c & 7, j = c >> 3, per = G >> 3;
        const int s0 = (int)(((long)n * x) >> 3), s1 = (int)(((long)n * (x + 1)) >> 3);
        const int L = s0 + i * per + j;
        if (L >= s1) return false;
        u.pm = L / nN; u.pn = L - u.pm * nN; return true;
    }
    __device__ __forceinline__ void a_ready(const Unit&) const {}
    __device__ __forceinline__ void done(const Unit&) const {}
};
template <class Epi, class Sched, bool STAMP = false>
__device__ __forceinline__ void gemm_phase(PG8_LAS unsigned char* lds, const Gemm g, const Sched& S, const Epi& E, unsigned long long* stamps) {
    const int tid = otid(), wid = __builtin_amdgcn_readfirstlane(tid >> 6), lane = tid & 63, wr = wid >> 2, wc = wid & 3, fr = lane & 15, fq = lane >> 4;
    const int K = g.K, nt = K / BK;
    int ts_lo = 0, ts_hi = 0, nts = 0; const unsigned long long rt_entry = STAMP ? (unsigned long long)wall_clock64() : 0ull;
#define PG8_STAMP() do { if (STAMP && wid == 0 && nts < 64) { const unsigned long long _c = (unsigned long long)clock64(); \
        ts_lo = (lane == nts) ? (int)(unsigned)_c : ts_lo; ts_hi = (lane == nts) ? (int)(unsigned)(_c >> 32) : ts_hi; ++nts; } } while (0)
    PG8_STAMP();
    unsigned voffA[2], voffB[2];
#pragma unroll
    for (int i = 0; i < 2; ++i) { int R, C; stage_rc(tid * 16 + i * 8192, R, C); const int Rb = Epi::PERM ? ((R & ~31) + perm32(R & 31)) : R;
        voffA[i] = (unsigned)(R * g.lda + C) * 2u; voffB[i] = (unsigned)(Rb * g.ldb + C) * 2u; }
    const size_t kstep = (size_t)(BK * 2);
    const size_t hstepA = (size_t)HALF * g.lda * 2, hstepB = (size_t)HALF * g.ldb * 2;
    const size_t tstepA = 2 * hstepA, tstepB = 2 * hstepB;
    const unsigned ldsw = (unsigned)wid * 1024u;
    const int aoff = lds_byte(wr * 64 + fr, fq * 8), boff = lds_byte(wc * 32 + fr, fq * 8);
#define PG8_SA(b, h) (((b) * 2 + (h)) * HTB)
#define PG8_SB(b, h) ((4 + (b) * 2 + (h)) * HTB)
#define PG8_STAGE(bufoff, gbase, voff) do { _Pragma("unroll") for (int _i = 0; _i < 2; ++_i) \
        __builtin_amdgcn_global_load_lds((const unsigned*)((const char*)(gbase) + (voff)[_i]), (PG8_LAS unsigned*)(lds + (bufoff) + ldsw + _i * 8192), 16, 0, 0); } while (0)
#define PG8_LDA(dst, b, h) do { _Pragma("unroll") for (int m = 0; m < 4; ++m) _Pragma("unroll") for (int k = 0; k < 2; ++k) dst[m][k] = *(const PG8_LAS bf16x8*)(lds + PG8_SA(b, h) + aoff + m * 2048 + k * 1024); } while (0)
#define PG8_LDB(dst, b, h) do { _Pragma("unroll") for (int n = 0; n < 2; ++n) _Pragma("unroll") for (int k = 0; k < 2; ++k) dst[n][k] = *(const PG8_LAS bf16x8*)(lds + PG8_SB(b, h) + boff + n * 2048 + k * 1024); } while (0)
#define PG8_MMA(ai, bj, At, Bt) do { __builtin_amdgcn_s_setprio(1); _Pragma("unroll") for (int m = 0; m < 4; ++m) _Pragma("unroll") for (int n = 0; n < 2; ++n) _Pragma("unroll") for (int k = 0; k < 2; ++k) \
        acc[ai][bj][m][n] = __builtin_amdgcn_mfma_f32_16x16x32_bf16(Bt[n][k], At[m][k], acc[ai][bj][m][n], 0, 0, 0); __builtin_amdgcn_s_setprio(0); } while (0)
#define PG8_WAIT_V(n) asm volatile("s_waitcnt vmcnt(" #n ")" ::: "memory")
#define PG8_WAIT_L(n) asm volatile("s_waitcnt lgkmcnt(" #n ")" ::: "memory")
#define PG8_BAR __builtin_amdgcn_s_barrier()
#define PG8_SCHED __builtin_amdgcn_sched_barrier(0)
    Unit cur, nxt; int ui = 0;
    if (!S.next(0, cur)) return;
    f32x4 acc[2][2][4][2];
#pragma unroll
    for (int a = 0; a < 2; ++a)
#pragma unroll
        for (int b = 0; b < 2; ++b)
#pragma unroll
            for (int m = 0; m < 4; ++m)
#pragma unroll
                for (int n = 0; n < 2; ++n) acc[a][b][m][n] = (f32x4){0.f, 0.f, 0.f, 0.f};
    bf16x8 At[4][2], B0[2][2], B1[2][2];
    const char* cA = (const char*)g.A + (size_t)cur.pm * tstepA; const char* cB = (const char*)g.Bt + (size_t)cur.pn * tstepB;
    S.a_ready(cur);
    PG8_STAGE(PG8_SB(0, 0), cB, voffB); PG8_STAGE(PG8_SA(0, 0), cA, voffA); PG8_STAGE(PG8_SB(0, 1), cB + hstepB, voffB); PG8_STAGE(PG8_SA(0, 1), cA + hstepA, voffA);
    if (wr == 1) PG8_BAR;
    PG8_WAIT_V(4); PG8_BAR;
    PG8_STAGE(PG8_SB(1, 0), cB + kstep, voffB); PG8_STAGE(PG8_SA(1, 0), cA + kstep, voffA); PG8_STAGE(PG8_SB(1, 1), cB + hstepB + kstep, voffB);
    PG8_WAIT_V(6); PG8_BAR;
    PG8_STAMP();
    for (;;) {
        const bool has_next = S.next(ui + 1, nxt);
        const char* nA = has_next ? (const char*)g.A + (size_t)nxt.pm * tstepA : cA; const char* nB = has_next ? (const char*)g.Bt + (size_t)nxt.pn * tstepB : cB;
        for (int t = 0; t < nt; t += 2) {
            const bool last = (t == nt - 2);
            const char* a1 = cA + (size_t)(t + 1) * kstep;
            const char* a2 = last ? nA : cA + (size_t)(t + 2) * kstep; const char* b2 = last ? nB : cB + (size_t)(t + 2) * kstep;
            const char* a3 = a2 + kstep; const char* b3 = b2 + kstep;
            if (last && has_next) S.a_ready(nxt);
            PG8_LDB(B0, 0, 0); PG8_SCHED; PG8_LDA(At, 0, 0); PG8_STAGE(PG8_SA(1, 1), a1 + hstepA, voffA);
            PG8_WAIT_L(8); PG8_BAR; PG8_WAIT_L(0); PG8_MMA(0, 0, At, B0); PG8_BAR; PG8_SCHED;
            PG8_LDB(B1, 0, 1); PG8_STAGE(PG8_SB(0, 0), b2, voffB);
            PG8_BAR; PG8_WAIT_L(0); PG8_MMA(0, 1, At, B1); PG8_BAR;
            PG8_LDA(At, 0, 1); PG8_STAGE(PG8_SA(0, 0), a2, voffA);
            PG8_BAR; PG8_WAIT_L(0); PG8_MMA(1, 0, At, B0); PG8_BAR; PG8_SCHED;
            PG8_STAGE(PG8_SB(0, 1), b2 + hstepB, voffB);
            PG8_WAIT_V(6); PG8_BAR; PG8_MMA(1, 1, At, B1); PG8_BAR;
            PG8_LDB(B0, 1, 0); PG8_SCHED; PG8_LDA(At, 1, 0); PG8_STAGE(PG8_SA(0, 1), a2 + hstepA, voffA);
            PG8_WAIT_L(8); PG8_BAR; PG8_WAIT_L(0); PG8_MMA(0, 0, At, B0); PG8_BAR; PG8_SCHED;
            PG8_LDB(B1, 1, 1); PG8_STAGE(PG8_SB(1, 0), b3, voffB);
            PG8_BAR; PG8_WAIT_L(0); PG8_MMA(0, 1, At, B1); PG8_BAR;
            PG8_LDA(At, 1, 1); PG8_STAGE(PG8_SA(1, 0), a3, voffA);
            PG8_BAR; PG8_WAIT_L(0); PG8_MMA(1, 0, At, B0); PG8_BAR; PG8_SCHED;
            PG8_STAGE(PG8_SB(1, 1), b3 + hstepB, voffB);
            PG8_WAIT_V(6); PG8_BAR; PG8_MMA(1, 1, At, B1); PG8_BAR;
        }
        PG8_STAMP();
        if constexpr (!Epi::AFTER_DRAIN) { E(acc, cur, wr, wc, fr, fq); S.done(cur); }
        PG8_STAMP();
        if (!has_next) break;
#pragma unroll
        for (int a = 0; a < 2; ++a)
#pragma unroll
            for (int b = 0; b < 2; ++b)
#pragma unroll
                for (int m = 0; m < 4; ++m)
#pragma unroll
                    for (int n = 0; n < 2; ++n) acc[a][b][m][n] = (f32x4){0.f, 0.f, 0.f, 0.f};
        cur = nxt; cA = nA; cB = nB; ++ui;
    }
    PG8_WAIT_V(0);
    if (wr == 0) PG8_BAR;
    PG8_BAR;
    if constexpr (Epi::AFTER_DRAIN) { E.fused(acc, cur, wr, wc, fr, fq, lds, wid, lane); S.done(cur); }
    PG8_STAMP();
    if (STAMP && wid == 0) { stamps[lane] = lane < nts ? (((unsigned long long)(unsigned)ts_hi << 32) | (unsigned)ts_lo) : 0ull;
        if (lane == 62) stamps[62] = rt_entry; if (lane == 63) stamps[63] = (unsigned long long)wall_clock64(); }
#undef PG8_STAMP
#undef PG8_SA
#undef PG8_SB
#undef PG8_STAGE
#undef PG8_LDA
#undef PG8_LDB
#undef PG8_MMA
#undef PG8_WAIT_V
#undef PG8_WAIT_L
#undef PG8_BAR
#undef PG8_SCHED
}
}

template <class Epi>
struct EpiAdapt { static constexpr bool PERM = false, AFTER_DRAIN = false; const Epi& e;
  __device__ __forceinline__ void operator()(const f32x4 (&acc)[2][2][4][2], const pg8::Unit& u, int wr, int wc, int fr, int fq) const { e(acc, u.pm, u.pn, wr, wc, fr, fq); } };
template <class Epi>
struct EpiAdaptP { static constexpr bool PERM = true, AFTER_DRAIN = false; const Epi& e;
  __device__ __forceinline__ void operator()(const f32x4 (&acc)[2][2][4][2], const pg8::Unit& u, int wr, int wc, int fr, int fq) const { e(acc, u.pm, u.pn, wr, wc, fr, fq); } };
template <class Epi>
DI void gemm_fast_p(char* lds, const bf16_t* A, int lda, const bf16_t* Bt, int ldb, int nM, int nN, int K, const Epi& epi) {
  asm volatile("" : "+s"(K), "+s"(lda), "+s"(ldb));
  pg8::Gemm g{A, Bt, lda, ldb, K}; pg8::RowOrder S{nN, nM * nN, (int)gridDim.x, (int)blockIdx.x}; EpiAdaptP<Epi> E{epi};
  __syncthreads();
  pg8::gemm_phase<EpiAdaptP<Epi>, pg8::RowOrder, false>((PG8_LAS unsigned char*)lds, g, S, E, nullptr);
  __syncthreads();
}
template <class F>
DI void epi_each8(const f32x4 (&acc)[2][2][4][2], int pm, int pn, int wr, int wc, int fr, int fq, const F& f) {
#pragma unroll
  for (int ai = 0; ai < 2; ++ai)
#pragma unroll
    for (int m = 0; m < 4; ++m) {
      const int row = pm * 256 + 128 * ai + 64 * wr + 16 * m + fr;
#pragma unroll
      for (int bj = 0; bj < 2; ++bj) f(row, pn * 256 + 128 * bj + 32 * wc + 8 * fq, acc[ai][bj][m][0], acc[ai][bj][m][1]);
    }
}
DI void st_bf8v(bf16_t* dst, f32x4 a, f32x4 b) { uint4 w; w.x = cvt_pk(a[0], a[1]); w.y = cvt_pk(a[2], a[3]); w.z = cvt_pk(b[0], b[1]); w.w = cvt_pk(b[2], b[3]); *(uint4*)dst = w; }
template <class Epi>
DI void gemm_fast(char* lds, const bf16_t* A, int lda, const bf16_t* Bt, int ldb, int nM, int nN, int K, const Epi& epi) {
  asm volatile("" : "+s"(K), "+s"(lda), "+s"(ldb));
  pg8::Gemm g{A, Bt, lda, ldb, K}; pg8::RowOrder S{nN, nM * nN, (int)gridDim.x, (int)blockIdx.x}; EpiAdapt<Epi> E{epi};
  __syncthreads();
  pg8::gemm_phase<EpiAdapt<Epi>, pg8::RowOrder, false>((PG8_LAS unsigned char*)lds, g, S, E, nullptr);
  __syncthreads();
}
DI void phase_p2x(PmK p, int l) {
  LAUNDER(p);
  const int tid_ = otid(), wid = tid_ >> 6, lane = tid_ & 63;
  bf16_t* dqkv = (bf16_t*)(p->ws + OFF_DQKV);
  const int hd = lane >> 2, part = lane & 3;
  const float* g = (hd < 8 ? p->dq_g : p->dk_g) + l * 64 + part * 16;
  float gv[16];
#pragma unroll
  for (int e = 0; e < 16; ++e) gv[e] = g[e];
  const float qs = hd < 8 ? 0.125f * LOG2E : 1.f;
  for (int r = blockIdx.x * 8 + wid; r < R; r += gridDim.x * 8) {
    const int b = r / TP, pp = r - b * TP;
    bf16_t* ptr = dqkv + (size_t)r * 1536 + lane * 16;
    float v[16]; ld_bf8(ptr, v); ld_bf8(ptr + 8, v + 8);
    float ss = 0.f;
#pragma unroll
    for (int e = 0; e < 16; ++e) ss += v[e] * v[e];
    ss += __shfl_xor(ss, 1); ss += __shfl_xor(ss, 2);
    const float rinv = rsqrtf(ss * (1.f / 64.f) + 1e-6f) * qs;
#pragma unroll
    for (int e = 0; e < 16; ++e) v[e] *= rinv * gv[e];
    if (part == 0) {
      const float t = (float)(pp - PAD0);
#pragma unroll
      for (int i = 0; i < 8; ++i) {
        float c, s; sincos_rev(t * p->inv_d[i], c, s);
        const float x1 = v[i], x2 = v[i + 8];
        v[i] = x1 * c - x2 * s; v[i + 8] = x2 * c + x1 * s;
      }
    }
    st_bf8(ptr, v); st_bf8(ptr + 8, v + 8);
  }
}

DI void phase_p3(PmK p, int l, char* lds) {
  LAUNDER(p);
  const int tid_ = otid(), wid = tid_ >> 6, lane = tid_ & 63;
  float* wl = (float*)lds + wid * 2048;
  float* sq = wl; float* sa = wl + 768; float* sk = wl + 1440; float* scs = wl + 1952; float* ssn = wl + 1968;
  bf16_t* mq = (bf16_t*)(p->ws + OFF_MQ); bf16_t* mk = (bf16_t*)(p->ws + OFF_MK);
  const bf16_t* pa = (const bf16_t*)(p->ws + OFF_PA); const bf16_t* knr = (const bf16_t*)(p->ws + OFF_KNR);
  const float* qg = p->q_head_g + l * 96; const float* kg = p->k_head_g + l * 96;
  const float qscale = 0.10206207261596577f * LOG2E;
  const int h = lane >> 3, e0 = (lane & 7) * 12;
  float gq[12], gk[12], gqp[12], gkp[12];
#pragma unroll
  for (int e = 0; e < 12; ++e) { const int d = e0 + e, pd = d < 16 ? d + 16 : (d < 32 ? d - 16 : d); gq[e] = qg[d]; gk[e] = kg[d]; gqp[e] = qg[pd]; gkp[e] = kg[pd]; }
  for (int r = blockIdx.x * 8 + wid; r < R; r += gridDim.x * 8) {
    const int b = r / TP, pp = r - b * TP;
    for (int i = lane; i < 192; i += 64) { const f32x4 v = ld_bf4(mq + (size_t)r * 768 + i * 4); *(f32x4*)(sq + i * 4) = v; }
    for (int i = lane; i < 168; i += 64) { const f32x4 v = ld_bf4(pa + (size_t)r * 672 + i * 4); *(f32x4*)(sa + i * 4) = v; }
    for (int i = lane; i < 128; i += 64) { const f32x4 v = ld_bf4(knr + (size_t)r * 512 + i * 4); *(f32x4*)(sk + i * 4) = v; }
    if (lane < 16) { float c, s; sincos_rev((float)(pp - PAD0) * p->inv_m[lane], c, s); scs[lane] = c; ssn[lane] = s; }
    asm volatile("s_waitcnt lgkmcnt(0)" ::: "memory");
    float s1 = 0.f, s2 = 0.f;
    for (int i = lane; i < 384; i += 64) s1 += sa[i] * sa[i];
    for (int i = lane; i < 256; i += 64) s2 += sa[384 + i] * sa[384 + i];
    s1 = wsum(s1); s2 = wsum(s2);
    const float rq = rsqrtf(s1 * (1.f / 384.f) + 1e-6f), rkv = rsqrtf(s2 * (1.f / 256.f) + 1e-6f);
    float ssq = 0.f, ssk = 0.f;
#pragma unroll
    for (int e = 0; e < 12; ++e) {
      const int d = e0 + e; const float qv = sq[h * 96 + d] * rq; ssq += qv * qv;
      const float kv = d < 32 ? sa[640 + d] : sk[h * 64 + d - 32] * rkv; ssk += kv * kv;
    }
    ssq += __shfl_xor(ssq, 1); ssq += __shfl_xor(ssq, 2); ssq += __shfl_xor(ssq, 4);
    ssk += __shfl_xor(ssk, 1); ssk += __shfl_xor(ssk, 2); ssk += __shfl_xor(ssk, 4);
    const float nq = rsqrtf(ssq * (1.f / 96.f) + 1e-6f) * rq * qscale, nk = rsqrtf(ssk * (1.f / 96.f) + 1e-6f);
    float oq[12], ok[12];
#pragma unroll
    for (int e = 0; e < 12; ++e) {
      const int d = e0 + e;
      const int pd = d < 16 ? d + 16 : d - 16;
      const float kraw = d < 32 ? sa[640 + d] : sk[h * 64 + d - 32] * rkv;
      const float qo = sq[h * 96 + d] * nq * gq[e], ko = kraw * nk * gk[e];
      if (d < 32) {
        const float qp = sq[h * 96 + pd] * nq * gqp[e], kp = sa[640 + pd] * nk * gkp[e];
        const float c = scs[d & 15], sn = ssn[d & 15];
        oq[e] = d < 16 ? qo * c - qp * sn : qo * c + qp * sn; ok[e] = d < 16 ? ko * c - kp * sn : ko * c + kp * sn;
      } else { oq[e] = qo; ok[e] = ko; }
    }
    asm volatile("s_waitcnt lgkmcnt(0)" ::: "memory");
    bf16_t* dq = mq + (size_t)r * 768 + lane * 12; bf16_t* dk = mk + (size_t)r * 768 + lane * 12;
#pragma unroll
    for (int e = 0; e < 12; e += 4) { st_bf4(dq + e, (f32x4){oq[e], oq[e + 1], oq[e + 2], oq[e + 3]}); st_bf4(dk + e, (f32x4){ok[e], ok[e + 1], ok[e + 2], ok[e + 3]}); }
    asm volatile("s_waitcnt lgkmcnt(0)" ::: "memory");
  }
}

DI void phase_p2y(PmK p, int l) {
  LAUNDER(p);
  const int tid_ = otid(), wid = tid_ >> 6, lane = tid_ & 63;
  const bf16_t* xr = (const bf16_t*)(p->ws + OFF_XBCR); bf16_t* xc = (bf16_t*)(p->ws + OFF_XBCC); float* gates = (float*)(p->ws + OFF_GATES);
  const float* cw = p->conv_w + (size_t)l * 5 * 768; const float* cb = p->conv_b + l * 768;
  const int c0 = lane * 12;
  float wreg[5][12], breg[12];
#pragma unroll
  for (int e = 0; e < 12; ++e) { breg[e] = cb[c0 + e];
#pragma unroll
    for (int j = 0; j < 5; ++j) wreg[j][e] = cw[j * 768 + c0 + e]; }
  for (int r = blockIdx.x * 8 + wid; r < R; r += gridDim.x * 8) {
    const int b = r / TP, pp = r - b * TP;
    bf16_t* dst = xc + (size_t)r * 768 + c0;
    if (pp < PAD0) {
      unsigned zz = 0u; asm volatile("" : "+v"(zz)); const uint2 z = {zz, zz};
      *(uint2*)dst = z; *(uint2*)(dst + 4) = z; *(uint2*)(dst + 8) = z;
      if (lane < 32) gates[(size_t)r * 32 + lane] = lane < 16 ? 0.f : (lane < 24 ? NEGF : 0.f);
      continue;
    }
    float acc[12];
#pragma unroll
    for (int e = 0; e < 12; ++e) acc[e] = breg[e];
#pragma unroll
    for (int j = 0; j < 5; ++j) {
      const int q = pp + j - 2;
      if (q >= PAD0 && q < TP) {
        const bf16_t* src = xr + (size_t)(r + j - 2) * 768 + c0;
#pragma unroll
        for (int e = 0; e < 12; e += 4) { const f32x4 v = ld_bf4(src + e);
          acc[e] += wreg[j][e] * v[0]; acc[e + 1] += wreg[j][e + 1] * v[1]; acc[e + 2] += wreg[j][e + 2] * v[2]; acc[e + 3] += wreg[j][e + 3] * v[3]; }
      }
    }
#pragma unroll
    for (int e = 0; e < 12; e += 4) st_bf4(dst + e, (f32x4){siluf(acc[e]), siluf(acc[e + 1]), siluf(acc[e + 2]), siluf(acc[e + 3])});
    if (lane < 32) {
      float v = gates[(size_t)r * 32 + lane];
      if (lane < 16) v = softplusf(v + p->dt_bias[l * 16 + lane]);
      else if (lane < 24) v = v + p->i_bias[l * 8 + lane - 16];
      else v = -softplusf(-(v + p->f_bias[l * 8 + lane - 24]));
      gates[(size_t)r * 32 + lane] = v;
    }
  }
}

DI void unpk8(const uint4 w, float* v) { v[0] = bflo(w.x); v[1] = bfhi(w.x); v[2] = bflo(w.y); v[3] = bfhi(w.y); v[4] = bflo(w.z); v[5] = bfhi(w.z); v[6] = bflo(w.w); v[7] = bfhi(w.w); }
DI void phase_post(PmK p, int l) {
  LAUNDER(p);
  const int tid_ = otid(), wid = tid_ >> 6, lane = tid_ & 63;
  bf16_t* mixed = (bf16_t*)(p->ws + OFF_MIXED); const bf16_t* sz = (const bf16_t*)(p->ws + OFF_SZ); const bf16_t* mo = (const bf16_t*)(p->ws + OFF_MQKVO);
  const float one_m_l = 1.f - p->linit[l];
  float g0[8], g1[8], g2[8], g3[8];
#pragma unroll
  for (int e = 0; e < 8; ++e) { g0[e] = p->mla_out_g[l * 512 + lane * 8 + e]; g1[e] = p->ssd_norm_g[l * 512 + lane * 8 + e];
    g2[e] = p->dout_g[l * 128 + (lane & 15) * 8 + e] * one_m_l; g3[e] = p->ml_out_g[l * 128 + (lane & 15) * 8 + e]; }
  for (int r = blockIdx.x * 8 + wid; r < R; r += gridDim.x * 8) {
    const int b = r / TP, pp = r - b * TP;
    if (pp < PAD0) continue;
    bf16_t* row = mixed + (size_t)r * 2048 + lane * 8;
    const uint4 w0 = *(const uint4*)row, w1 = *(const uint4*)(row + 512), w2 = *(const uint4*)(row + 1024), w3 = *(const uint4*)(row + 1536);
    const uint4 wz = *(const uint4*)(sz + (size_t)r * 512 + lane * 8), wo = *(const uint4*)(mo + (size_t)r * 1536 + 1024 + lane * 8);
    float v0[8], v1[8], v2[8], v3[8], z[8], og[8];
    unpk8(w0, v0); unpk8(w1, v1); unpk8(w2, v2); unpk8(w3, v3); unpk8(wz, z); unpk8(wo, og);
    float s0 = 0.f, s1 = 0.f, s2 = 0.f, s3 = 0.f;
#pragma unroll
    for (int e = 0; e < 8; ++e) { v1[e] *= siluf(z[e]); s0 += v0[e] * v0[e]; s1 += v1[e] * v1[e]; s2 += v2[e] * v2[e]; s3 += v3[e] * v3[e]; }
#pragma unroll
    for (int m = 1; m <= 8; m <<= 1) { s0 += __shfl_xor(s0, m); s1 += __shfl_xor(s1, m); s2 += __shfl_xor(s2, m); s3 += __shfl_xor(s3, m); }
    s0 += __shfl_xor(s0, 16); s1 += __shfl_xor(s1, 16); s0 += __shfl_xor(s0, 32); s1 += __shfl_xor(s1, 32);
    const float r0 = rsqrtf(s0 * (1.f / 512.f) + 1e-6f), r1 = rsqrtf(s1 * (1.f / 512.f) + 1e-6f), r2 = rsqrtf(s2 * (1.f / 128.f) + 1e-6f), r3 = rsqrtf(s3 * (1.f / 128.f) + 1e-6f);
#pragma unroll
    for (int e = 0; e < 8; ++e) { v0[e] *= r0 * g0[e]; v1[e] *= r1 * g1[e]; v2[e] *= r2 * g2[e]; v3[e] *= r3 * g3[e] * sigmf(og[e]); }
    st_bf8(row, v0); st_bf8(row + 512, v1); st_bf8(row + 1024, v2); st_bf8(row + 1536, v3);
  }
}

DI void vtrans_items(PmK p, char* lds) {
  LAUNDER(p);
  const int tid = otid();
  bf16_t* T = (bf16_t*)lds;
  float* s_r = (float*)(T + 64 * 520);
  const bf16_t* pa = (const bf16_t*)(p->ws + OFF_PA); const bf16_t* mvr = (const bf16_t*)(p->ws + OFF_MVR); const bf16_t* dqkv = (const bf16_t*)(p->ws + OFF_DQKV);
  bf16_t* mvt = (bf16_t*)(p->ws + OFF_MVT); bf16_t* dvt = (bf16_t*)(p->ws + OFF_DVT);
  for (int it = blockIdx.x; it < 2 * NB * 130; it += gridDim.x) {
    const int which = it / (NB * 130), rem = it - which * (NB * 130), b = rem / 130, pc = rem - b * 130, r0 = b * TP + pc * 64;
    __syncthreads();
    if (which == 0) {
      const int row = tid >> 3, sub = tid & 7; float ss = 0.f;
#pragma unroll
      for (int e = 0; e < 4; ++e) { float v[8]; ld_bf8(pa + (size_t)(r0 + row) * 672 + 384 + sub * 32 + e * 8, v);
#pragma unroll
        for (int q = 0; q < 8; ++q) ss += v[q] * v[q]; }
      ss += __shfl_xor(ss, 1); ss += __shfl_xor(ss, 2); ss += __shfl_xor(ss, 4);
      if (sub == 0) s_r[row] = rsqrtf(ss * (1.f / 256.f) + 1e-6f);
    }
    __syncthreads();
    const bf16_t* src = which ? dqkv + 1024 : mvr; const int ld = which ? 1536 : 512;
#pragma unroll
    for (int i = 0; i < 8; ++i) {
      const int id = tid + 512 * i, row = id >> 6, cc = id & 63;
      if (which) *(uint4*)(T + row * 520 + cc * 8) = *(const uint4*)(src + (size_t)(r0 + row) * ld + cc * 8);
      else { float v[8]; ld_bf8(src + (size_t)(r0 + row) * ld + cc * 8, v); const float sc = s_r[row];
#pragma unroll
        for (int q = 0; q < 8; ++q) v[q] *= sc;
        st_bf8(T + row * 520 + cc * 8, v); }
    }
    __syncthreads();
    bf16_t* dT = (which ? dvt : mvt) + (size_t)b * 512 * TP + pc * 64;
#pragma unroll
    for (int i = 0; i < 8; ++i) {
      const int id = tid + 512 * i, c = id >> 3, pch = id & 7;
      bf16x8 o;
#pragma unroll
      for (int e = 0; e < 8; ++e) { const int pd = pch * 8 + e, ps = (pd & ~12) | ((pd & 4) << 1) | ((pd & 8) >> 1);
        o[e] = (short)T[ps * 520 + c]; }
      *(bf16x8*)(dT + (size_t)c * TP + pch * 8) = o;
    }
  }
  __syncthreads();
}

typedef float f32x16 __attribute__((ext_vector_type(16)));
#define MFMA32(a, b, c) __builtin_amdgcn_mfma_f32_32x32x16_bf16((a), (b), (c), 0, 0, 0)
DI int crow(int i, int hi) { return (i & 3) + 8 * (i >> 2) + 4 * hi; }

template <int DQK, int DV, bool SECOND>
DI void attn32(char* lds, const bf16_t* __restrict__ Qb, int ldq, const bf16_t* __restrict__ Kb, int ldk, const bf16_t* __restrict__ VTb, int q0,
               bf16_t* dstb, float lam) {
  constexpr int KS = DQK + 8, VS = 72, NKS = DQK / 16, NDB = DV / 32, KCH = DQK / 8;
  constexpr int NK = 64 * KCH, NV = DV * 8, NCHK = NK + NV, CI = (NCHK + 511) / 512, NT = TP / 64, KBUF = 64 * KS, VBUF = DV * VS;
  bf16_t* LK = (bf16_t*)lds; bf16_t* LV = LK + 2 * KBUF;
  const int tid = otid(), wid = tid >> 6, lane = tid & 63, r32 = lane & 31, hi = lane >> 5;
  const int prow = q0 + 32 * wid + r32, pc = prow < 0 ? 0 : prow;
  const bool active = __builtin_amdgcn_readfirstlane(q0 + 32 * wid + 31) >= PAD0;
  bf16x8 qf[NKS];
#pragma unroll
  for (int ks = 0; ks < NKS; ++ks) qf[ks] = *(const bf16x8*)(Qb + (size_t)pc * ldq + 16 * ks + 8 * hi);
  f32x16 o[NDB];
#pragma unroll
  for (int db = 0; db < NDB; ++db)
#pragma unroll
    for (int i = 0; i < 16; ++i) o[db][i] = 0.f;
  float m = NEGF, lsum = 0.f;
  bf16x8 st[CI];
#define A32_GLOAD(ktk, ktv) do { int tl_ = tid; asm volatile("" : "+v"(tl_)); _Pragma("unroll") for (int i = 0; i < CI; ++i) { const int id0 = tl_ + 512 * i, id = id0 < NCHK ? id0 : NCHK - 1; { \
      if (id < NK) { const int row = id / KCH, cc = id - row * KCH; st[i] = *(const bf16x8*)(Kb + (size_t)((ktk) * 64 + row) * ldk + cc * 8); } \
      else { const int v = id - NK, d = v >> 3, cc = v & 7; st[i] = *(const bf16x8*)(VTb + (size_t)d * TP + (ktv) * 64 + cc * 8); } } } } while (0)
#define A32_LSTORE(kbuf, vbuf, dok, dov) do { int tl_ = tid; asm volatile("" : "+v"(tl_)); _Pragma("unroll") for (int i = 0; i < CI; ++i) { const int id = tl_ + 512 * i; if (id < NCHK) { \
      if (id < NK) { if (dok) { const int row = id / KCH, cc = id - row * KCH; *(bf16x8*)(LK + (kbuf) * KBUF + row * KS + cc * 8) = st[i]; } } \
      else { if (dov) { const int v = id - NK, d = v >> 3, cc = v & 7; *(bf16x8*)(LV + (vbuf) * VBUF + d * VS + cc * 8) = st[i]; } } } } } while (0)
#define A32_QK(S0, S1, kt) do { const bf16_t* Ks = LK + ((kt) & 1) * KBUF; \
    _Pragma("unroll") for (int i = 0; i < 16; ++i) { S0[i] = 0.f; S1[i] = 0.f; } \
    _Pragma("unroll") for (int ks = 0; ks < NKS; ++ks) { \
      const bf16x8 ka0 = *(const bf16x8*)(Ks + r32 * KS + 16 * ks + 8 * hi), ka1 = *(const bf16x8*)(Ks + (32 + r32) * KS + 16 * ks + 8 * hi); \
      S0 = MFMA32(ka0, qf[ks], S0); S1 = MFMA32(ka1, qf[ks], S1); } } while (0)
#define A32_SOFT_PV(S0, S1, kt) do { \
    float mxa = fmaxf(S0[0], S0[1]), mxb = fmaxf(S1[0], S1[1]); \
    _Pragma("unroll") for (int i = 2; i < 16; i += 2) { mxa = fmaxf(mxa, fmaxf(S0[i], S0[i + 1])); mxb = fmaxf(mxb, fmaxf(S1[i], S1[i + 1])); } \
    float mx = fmaxf(mxa, mxb); mx = fmaxf(mx, __shfl_xor(mx, 32)); \
    const float mn = fmaxf(m, mx), alpha = __builtin_amdgcn_exp2f(m - mn); m = mn; \
    const f32x2 mn2 = {mn, mn}, al2 = {alpha, alpha}; f32x2 rsa = {0.f, 0.f}, rsb = {0.f, 0.f}; \
    _Pragma("unroll") for (int i = 0; i < 16; i += 2) { \
      f32x2 t = (f32x2){S0[i], S0[i + 1]} - mn2; t[0] = __builtin_amdgcn_exp2f(t[0]); t[1] = __builtin_amdgcn_exp2f(t[1]); rsa += t; S0[i] = t[0]; S0[i + 1] = t[1]; \
      f32x2 u = (f32x2){S1[i], S1[i + 1]} - mn2; u[0] = __builtin_amdgcn_exp2f(u[0]); u[1] = __builtin_amdgcn_exp2f(u[1]); rsb += u; S1[i] = u[0]; S1[i + 1] = u[1]; } \
    lsum = lsum * alpha + ((rsa[0] + rsa[1]) + (rsb[0] + rsb[1])); \
    _Pragma("unroll") for (int db = 0; db < NDB; ++db) _Pragma("unroll") for (int i = 0; i < 16; i += 2) { const f32x2 t = (f32x2){o[db][i], o[db][i + 1]} * al2; o[db][i] = t[0]; o[db][i + 1] = t[1]; } \
    const bf16_t* Vt = LV + ((kt) & 1) * VBUF; \
    _Pragma("unroll") for (int s4 = 0; s4 < 4; ++s4) { const int b8 = 8 * (s4 & 1); u32x4 w; \
      if (s4 < 2) w = (u32x4){cvt_pk(S0[b8], S0[b8 + 1]), cvt_pk(S0[b8 + 2], S0[b8 + 3]), cvt_pk(S0[b8 + 4], S0[b8 + 5]), cvt_pk(S0[b8 + 6], S0[b8 + 7])}; \
      else w = (u32x4){cvt_pk(S1[b8], S1[b8 + 1]), cvt_pk(S1[b8 + 2], S1[b8 + 3]), cvt_pk(S1[b8 + 4], S1[b8 + 5]), cvt_pk(S1[b8 + 6], S1[b8 + 7])}; \
      const bf16x8 pb = __builtin_bit_cast(bf16x8, w); \
      _Pragma("unroll") for (int db = 0; db < NDB; ++db) { const bf16x8 va = *(const bf16x8*)(Vt + (db * 32 + r32) * VS + 16 * s4 + 8 * hi); o[db] = MFMA32(va, pb, o[db]); } } } while (0)
#define A32_STEP(C0, C1, N0, N1, kt) do { \
    if (active) { if ((kt) + 1 < NT) A32_QK(N0, N1, (kt) + 1); \
    A32_SOFT_PV(C0, C1, kt); } \
    A32_LSTORE(kt & 1, ((kt) + 1) & 1, (kt) + 2 < NT, (kt) + 1 < NT); \
    __syncthreads(); \
    A32_GLOAD(((kt) + 3 < NT ? (kt) + 3 : NT - 1), ((kt) + 2 < NT ? (kt) + 2 : NT - 1)); } while (0)
  f32x16 sa0, sa1, sb0, sb1;
  A32_GLOAD(1, 1); A32_LSTORE(1, 1, true, true); A32_GLOAD(2, 2); __syncthreads();
  A32_QK(sa0, sa1, 1);
#pragma unroll
  for (int i = 0; i < 16; ++i) { if (crow(i, hi) < 48) sa0[i] = NEGF; if (32 + crow(i, hi) < 48) sa1[i] = NEGF; }
  A32_LSTORE(0, 0, true, false); __syncthreads(); A32_GLOAD(3, 2);
#pragma unroll 1
  for (int kt = 1; kt + 1 < NT; kt += 2) {
    A32_STEP(sa0, sa1, sb0, sb1, kt);
    A32_STEP(sb0, sb1, sa0, sa1, kt + 1);
  }
  A32_STEP(sa0, sa1, sb0, sb1, NT - 1);
#undef A32_GLOAD
#undef A32_LSTORE
#undef A32_QK
#undef A32_SOFT_PV
#undef A32_STEP
  lsum += __shfl_xor(lsum, 32);
  const float il = 1.f / lsum;
  if (prow >= PAD0) {
    bf16_t* drow = dstb + (size_t)prow * 2048 + 4 * hi;
#pragma unroll
    for (int db = 0; db < NDB; ++db)
#pragma unroll
      for (int g = 0; g < 4; ++g) {
        f32x4 v = {o[db][4 * g] * il, o[db][4 * g + 1] * il, o[db][4 * g + 2] * il, o[db][4 * g + 3] * il};
        bf16_t* ad = drow + db * 32 + 8 * g;
        if (SECOND) { const f32x4 pv = ld_bf4(ad); v = pv - lam * v; }
        st_bf4(ad, v);
      }
  }
  __syncthreads();
}

DI void phase_attn(PmK p, char* lds, int cslot) {
  LAUNDER(p);
  const int tid = otid();
  bf16_t* mixed = (bf16_t*)(p->ws + OFF_MIXED);
  const bf16_t* dqkv = (const bf16_t*)(p->ws + OFF_DQKV);
  const bf16_t* mq = (const bf16_t*)(p->ws + OFF_MQ); const bf16_t* mk = (const bf16_t*)(p->ws + OFF_MK);
  const bf16_t* mvt = (const bf16_t*)(p->ws + OFF_MVT); const bf16_t* dvt = (const bf16_t*)(p->ws + OFF_DVT);
  const float lam = ((const float*)(p->ws + OFF_SCAL))[0];
  int* counter = (int*)(p->ws + OFF_SCAL) + 16 + cslot;
  int* s_it = (int*)(lds + 120 * 1024);
  constexpr int NQ = 33, ND = NB * 4 * NQ, NM = NB * 8 * NQ;
  for (;;) {
    __syncthreads();
    if (tid == 0) *s_it = atomicAdd(counter, 1);
    __syncthreads();
    const int it = *s_it;
    if (it >= ND + NM) break;
    bool isd; int qi, bh;
    if (it < 48) { isd = it < 16; bh = isd ? it : it - 16; qi = 0; }
    else if (it < 48 + 16 * 32) { const int t = it - 48; isd = true; bh = t >> 5; qi = (t & 31) + 1; }
    else { const int t = it - 48 - 16 * 32; isd = false; bh = t >> 5; qi = (t & 31) + 1; }
    const int q0 = 256 * qi - 128;
    if (isd) {
      const int h = bh & 3, b = bh >> 2;
      const bf16_t* base = dqkv + (size_t)b * TP * 1536;
      const bf16_t* vt = dvt + ((size_t)b * 512 + h * 128) * TP;
      bf16_t* dst = mixed + (size_t)b * TP * 2048 + 1024 + h * 128;
      attn32<64, 128, false>(lds, base + (2 * h) * 64, 1536, base + 512 + (2 * h) * 64, 1536, vt, q0, dst, lam);
      attn32<64, 128, true>(lds, base + (2 * h + 1) * 64, 1536, base + 512 + (2 * h + 1) * 64, 1536, vt, q0, dst, lam);
    } else {
      const int h = bh & 7, b = bh >> 3;
      attn32<96, 64, false>(lds, mq + (size_t)b * TP * 768 + h * 96, 768, mk + (size_t)b * TP * 768 + h * 96, 768, mvt + ((size_t)b * 512 + h * 64) * TP, q0,
                            mixed + (size_t)b * TP * 2048 + h * 64, lam);
    }
  }
}

DI void phase_states(PmK p, int l, char* lds) {
  LAUNDER(p);
  const int tid = otid(), wid = tid >> 6, lane = tid & 63, fr = lane & 15, fq = lane >> 4;
  const bf16_t* xc = (const bf16_t*)(p->ws + OFF_XBCC); const float* gates = (const float*)(p->ws + OFF_GATES);
  const bf16_t* mqk = (const bf16_t*)(p->ws + OFF_MQKVO);
  float* ssds = (float*)(p->ws + OFF_SSDS); float* ssdd = (float*)(p->ws + OFF_SSDD);
  float* mls = (float*)(p->ws + OFF_MLS); float* mlg = (float*)(p->ws + OFF_MLG);
  bf16_t* T0 = (bf16_t*)lds;
  bf16_t* T1 = T0 + 64 * 136;
  float* s_a = (float*)(T1 + 144 * 136); float* s_b = s_a + 128; float* s_cum = s_b + 128; float* s_sc = s_cum + 128;
  constexpr int NS = NB * NCH * 8 * 2, NMI = NB * NCH * 4 * 2;
  for (int it = blockIdx.x; it < NS + NMI; it += gridDim.x) {
    __syncthreads();
    if (it < NS) {
      const int dir = it & 1, hh = (it >> 1) & 7, bc = it >> 4, c = bc % NCH, b = bc / NCH, g = hh >> 2;
      const int r0 = b * TP + c * 128;
      const float Ah = -expf(p->a_log[l * 16 + dir * 8 + hh]);
      if (tid < 128) { const float dtv = gates[(size_t)(r0 + tid) * 32 + dir * 8 + hh]; s_b[tid] = dtv; s_a[tid] = dtv * Ah; }
      __syncthreads();
      if (wid == 0) scan128_sum(s_a, s_cum, dir, lane);
      __syncthreads();
      const float tot = dir ? s_cum[0] : s_cum[127];
#pragma unroll
      for (int i = 0; i < 2; ++i) {
        const int id = tid + 512 * i, lrow = id >> 3, c8 = id & 7;
        float xv[8]; ld_bf8(xc + (size_t)(r0 + lrow) * 768 + hh * 64 + c8 * 8, xv);
        const uint4 bw = *(const uint4*)(xc + (size_t)(r0 + lrow) * 768 + 512 + g * 64 + c8 * 8);
        const bf16x8 bv = __builtin_bit_cast(bf16x8, bw);
        const float sc = s_b[lrow] * fexp(tot - s_cum[lrow]);
#pragma unroll
        for (int e = 0; e < 8; ++e) { T0[(c8 * 8 + e) * 136 + lrow] = f2bf(xv[e] * sc); T1[(c8 * 8 + e) * 136 + lrow] = (bf16_t)bv[e]; }
      }
      __syncthreads();
      const int cp = dir ? NCH - 1 - c : c;
      const size_t sidx = (size_t)((b * 8 + hh) * 2 + dir) * NCH + cp;
      for (int t = wid; t < 16; t += 8) {
        const int nt = t & 3, pt = t >> 2;
        const f32x4 acc = mma_lds(T1 + nt * 16 * 136, 136, T0 + pt * 16 * 136, 136, 128, (f32x4){0.f, 0.f, 0.f, 0.f}, fr, fq);
        *(f32x4*)(ssds + sidx * 4096 + (pt * 16 + fr) * 64 + nt * 16 + 4 * fq) = acc;
      }
      if (tid == 0) ssdd[sidx] = fexp(tot);
    } else {
      const int i2 = it - NS, dir = i2 & 1, hm = (i2 >> 1) & 3, bc = i2 >> 3, c = bc % NCH, b = bc / NCH;
      const int r0 = b * TP + c * 128;
      if (tid < 128) { s_a[tid] = gates[(size_t)(r0 + tid) * 32 + 24 + dir * 4 + hm]; s_b[tid] = gates[(size_t)(r0 + tid) * 32 + 16 + dir * 4 + hm]; }
      __syncthreads();
      if (wid == 0) scan128_sum(s_a, s_cum, dir, lane);
      __syncthreads();
      const float glast = dir ? s_cum[0] : s_cum[127];
      if (wid == 0) {
        float mx = fmaxf(glast - s_cum[lane] + s_b[lane], glast - s_cum[lane + 64] + s_b[lane + 64]);
        mx = wmax(mx); if (lane == 0) s_sc[0] = mx;
      }
      __syncthreads();
      const float mloc = s_sc[0];
#pragma unroll
      for (int i = 0; i < 2; ++i) {
        const int id = tid + 512 * i, lrow = id >> 3, c8 = id & 7;
        const uint4 kw = *(const uint4*)(mqk + (size_t)(r0 + lrow) * 1536 + 256 + hm * 64 + c8 * 8);
        const bf16x8 kv = __builtin_bit_cast(bf16x8, kw);
#pragma unroll
        for (int e = 0; e < 8; ++e) T0[(c8 * 8 + e) * 136 + lrow] = (bf16_t)kv[e];
      }
#pragma unroll
      for (int i = 0; i < 4; ++i) {
        const int id = tid + 512 * i, lrow = id >> 4, c8 = id & 15;
        float vv[8]; ld_bf8(mqk + (size_t)(r0 + lrow) * 1536 + 512 + hm * 128 + c8 * 8, vv);
        const float w = fexp(glast - s_cum[lrow] + s_b[lrow] - mloc);
#pragma unroll
        for (int e = 0; e < 8; ++e) T1[(c8 * 8 + e) * 136 + lrow] = f2bf(vv[e] * w);
      }
      for (int id = tid; id < 16 * 128; id += 512) {
        const int vr = id >> 7, lrow = id & 127;
        T1[(128 + vr) * 136 + lrow] = vr == 0 ? f2bf(fexp(glast - s_cum[lrow] + s_b[lrow] - mloc)) : (bf16_t)0;
      }
      __syncthreads();
      const int cp = dir ? NCH - 1 - c : c;
      const size_t sidx = (size_t)((b * 4 + hm) * 2 + dir) * NCH + cp;
      for (int t = wid; t < 36; t += 8) {
        const int dt_ = t & 3, vt = t >> 2;
        const f32x4 acc = mma_lds(T0 + dt_ * 16 * 136, 136, T1 + vt * 16 * 136, 136, 128, (f32x4){0.f, 0.f, 0.f, 0.f}, fr, fq);
        *(f32x4*)(mls + sidx * 9216 + (vt * 16 + fr) * 64 + dt_ * 16 + 4 * fq) = acc;
      }
      if (tid == 0) { mlg[sidx * 3] = glast; mlg[sidx * 3 + 1] = mloc; }
    }
  }
  __syncthreads();
}

DI void phase_scan(PmK p) {
  LAUNDER(p);
  float* ssds = (float*)(p->ws + OFF_SSDS); const float* ssdd = (const float*)(p->ws + OFF_SSDD);
  float* mls = (float*)(p->ws + OFF_MLS); float* mlg = (float*)(p->ws + OFF_MLG);
  const int gt = blockIdx.x * 512 + otid(), gn = gridDim.x * 512;
  for (int e0 = gt; e0 < 64 * 4096; e0 += 2 * gn) {
    const int e1 = e0 + gn < 64 * 4096 ? e0 + gn : e0;
    const int ch0 = e0 >> 12, el0 = e0 & 4095, ch1 = e1 >> 12, el1 = e1 & 4095;
    float run0 = 0.f, run1 = 0.f;
#pragma unroll 1
    for (int c0 = 0; c0 < NCH; c0 += 13) {
      float t0[13], d0[13], t1[13], d1[13];
#pragma unroll
      for (int j = 0; j < 13; ++j) { t0[j] = ssds[(size_t)(ch0 * NCH + c0 + j) * 4096 + el0]; d0[j] = ssdd[ch0 * NCH + c0 + j];
                                     t1[j] = ssds[(size_t)(ch1 * NCH + c0 + j) * 4096 + el1]; d1[j] = ssdd[ch1 * NCH + c0 + j]; }
#pragma unroll
      for (int j = 0; j < 13; ++j) {
        ssds[(size_t)(ch0 * NCH + c0 + j) * 4096 + el0] = run0; run0 = run0 * d0[j] + t0[j];
        if (e1 != e0) { ssds[(size_t)(ch1 * NCH + c0 + j) * 4096 + el1] = run1; run1 = run1 * d1[j] + t1[j]; }
      }
    }
  }
  for (int e = gt; e < 32 * 9216; e += gn) {
    const int chain = e / 9216, el = e - chain * 9216; float run = 0.f, m = NEGF;
#pragma unroll 1
    for (int c0 = 0; c0 < NCH; c0 += 13) {
      float t[13], gl[13], ml[13];
#pragma unroll
      for (int j = 0; j < 13; ++j) { const int ci = chain * NCH + c0 + j; t[j] = mls[(size_t)ci * 9216 + el]; gl[j] = mlg[ci * 3]; ml[j] = mlg[ci * 3 + 1]; }
#pragma unroll
      for (int j = 0; j < 13; ++j) {
        const int ci = chain * NCH + c0 + j;
        mls[(size_t)ci * 9216 + el] = run;
        if (el == 0) mlg[ci * 3 + 2] = m;
        const float mn = fmaxf(gl[j] + m, ml[j]);
        run = fexp(gl[j] + m - mn) * run + fexp(ml[j] - mn) * t[j]; m = mn;
      }
    }
  }
}

DI void phase_out(PmK p, int l, char* lds) {
  LAUNDER(p);
  const int tid = otid(), wid = tid >> 6, lane = tid & 63, fr = lane & 15, fq = lane >> 4;
  const bf16_t* xc = (const bf16_t*)(p->ws + OFF_XBCC); const float* gates = (const float*)(p->ws + OFF_GATES);
  const bf16_t* mqk = (const bf16_t*)(p->ws + OFF_MQKVO);
  const float* ssds = (const float*)(p->ws + OFF_SSDS); const float* mls = (const float*)(p->ws + OFF_MLS); const float* mlg = (const float*)(p->ws + OFF_MLG);
  bf16_t* mixed = (bf16_t*)(p->ws + OFF_MIXED);
  bf16_t* A0 = (bf16_t*)lds; bf16_t* A1 = A0 + 128 * 72; bf16_t* Vt = A1 + 128 * 72; bf16_t* Ms = Vt + 144 * 136; bf16_t* St = Ms + 128 * 136;
  float* s_a = (float*)(St + 144 * 72); float* s_b = s_a + 128; float* s_cum = s_b + 128; float* s_pm = s_cum + 128;
  constexpr int NS = NB * NCH * 8, NMI = NB * NCH * 4;
  const f32x4 zero4 = {0.f, 0.f, 0.f, 0.f};
  int* const qcnt = (int*)(p->ws + OFF_SCAL) + 18; int* const s_q = (int*)(lds + 136 * 1024);
  for (;;) {
    __syncthreads();
    if (tid == 0) *s_q = atomicAdd(qcnt, 1);
    __syncthreads();
    const int it = *s_q;
    if (it >= NS) break;
    {
      const int hh = it & 7, bc = it >> 3, c = bc % NCH, b = bc / NCH, g = hh >> 2;
      const int r0 = b * TP + c * 128;
#pragma unroll
      for (int i = 0; i < 2; ++i) {
        const int id = tid + 512 * i, lrow = id >> 3, c8 = id & 7;
        *(uint4*)(A0 + lrow * 72 + c8 * 8) = *(const uint4*)(xc + (size_t)(r0 + lrow) * 768 + 640 + g * 64 + c8 * 8);
        *(uint4*)(A1 + lrow * 72 + c8 * 8) = *(const uint4*)(xc + (size_t)(r0 + lrow) * 768 + 512 + g * 64 + c8 * 8);
      }
      __syncthreads();
      f32x4 yacc[4] = {zero4, zero4, zero4, zero4};
      const int lrow_me = 16 * wid + fr;
      for (int dir = 0; dir < 2; ++dir) {
        __syncthreads();
        const float Ah = -expf(p->a_log[l * 16 + dir * 8 + hh]);
        if (tid < 128) { const float dtv = gates[(size_t)(r0 + tid) * 32 + dir * 8 + hh]; s_b[tid] = dtv; s_a[tid] = dtv * Ah; }
        __syncthreads();
        if (wid == 0) scan128_sum(s_a, s_cum, dir, lane);
        __syncthreads();
#pragma unroll
        for (int i = 0; i < 2; ++i) {
          const int id = tid + 512 * i, lrow = id >> 3, c8 = id & 7;
          float xv[8]; ld_bf8(xc + (size_t)(r0 + lrow) * 768 + hh * 64 + c8 * 8, xv);
          const float sc = s_b[lrow];
#pragma unroll
          for (int e = 0; e < 8; ++e) Vt[(c8 * 8 + e) * 136 + lrow] = f2bf(xv[e] * sc);
        }
        const int cp = dir ? NCH - 1 - c : c;
        const size_t sidx = (size_t)((b * 8 + hh) * 2 + dir) * NCH + cp;
#pragma unroll
        for (int i = 0; i < 2; ++i) {
          const int id = tid + 512 * i;
          const f32x4 v = *(const f32x4*)(ssds + sidx * 4096 + id * 4);
          st_bf4(St + (id >> 4) * 72 + (id & 15) * 4, v);
        }
        const float cl = s_cum[lrow_me];
        int lrow_v = lrow_me; asm volatile("" : "+v"(lrow_v));
#pragma unroll 1
        for (int st = 0; st < 8; ++st) {
          f32x4 mv;
          const f32x4 gt_ = mma_lds(A1 + st * 16 * 72, 72, A0 + wid * 16 * 72, 72, 64, zero4, fr, fq);
#pragma unroll
          for (int j = 0; j < 4; ++j) {
            const int s = 16 * st + 4 * fq + j;
            const bool ok = dir ? (s >= lrow_v) : (s <= lrow_v);
            mv[j] = ok ? gt_[j] * fexp(fminf(cl - s_cum[s], 0.f)) : 0.f;
          }
          st_bf4(Ms + lrow_me * 136 + 16 * st + 4 * fq, mv);
        }
        __syncthreads();
        const float el = fexp(cl);
#pragma unroll
        for (int pt = 0; pt < 4; ++pt) {
          const f32x4 a1 = mma_lds(Vt + pt * 16 * 136, 136, Ms + wid * 16 * 136, 136, 128, zero4, fr, fq);
          const f32x4 a2 = mma_lds(St + pt * 16 * 72, 72, A0 + wid * 16 * 72, 72, 64, zero4, fr, fq);
          yacc[pt] += a1 + el * a2;
        }
      }
      const int pp = c * 128 + lrow_me;
      if (pp >= PAD0) {
        const float dsk = p->ssd_d[l * 8 + hh];
        const size_t r = (size_t)r0 + lrow_me;
#pragma unroll
        for (int pt = 0; pt < 4; ++pt) {
          const f32x4 xs = ld_bf4(xc + r * 768 + hh * 64 + pt * 16 + 4 * fq);
          st_bf4(mixed + r * 2048 + 512 + hh * 64 + pt * 16 + 4 * fq, yacc[pt] + dsk * xs);
        }
      }
    }
  }
  for (;;) {
    __syncthreads();
    if (tid == 0) *s_q = atomicAdd(qcnt + 1, 1);
    __syncthreads();
    const int i2 = *s_q;
    if (i2 >= NMI) break;
    {
      const int hm = i2 & 3, bc = i2 >> 2, c = bc % NCH, b = bc / NCH;
      const int r0 = b * TP + c * 128;
#pragma unroll
      for (int i = 0; i < 2; ++i) {
        const int id = tid + 512 * i, lrow = id >> 3, c8 = id & 7;
        float qv[8]; ld_bf8(mqk + (size_t)(r0 + lrow) * 1536 + hm * 64 + c8 * 8, qv);
#pragma unroll
        for (int e = 0; e < 8; ++e) qv[e] *= 0.125f;
        st_bf8(A0 + lrow * 72 + c8 * 8, qv);
        *(uint4*)(A1 + lrow * 72 + c8 * 8) = *(const uint4*)(mqk + (size_t)(r0 + lrow) * 1536 + 256 + hm * 64 + c8 * 8);
      }
#pragma unroll
      for (int i = 0; i < 4; ++i) {
        const int id = tid + 512 * i, lrow = id >> 4, c8 = id & 15;
        const uint4 vw = *(const uint4*)(mqk + (size_t)(r0 + lrow) * 1536 + 512 + hm * 128 + c8 * 8);
        const bf16x8 vv = __builtin_bit_cast(bf16x8, vw);
#pragma unroll
        for (int e = 0; e < 8; ++e) Vt[(c8 * 8 + e) * 136 + lrow] = (bf16_t)vv[e];
      }
      for (int id = tid; id < 16 * 128; id += 512) { const int vr = id >> 7, lrow = id & 127; Vt[(128 + vr) * 136 + lrow] = vr == 0 ? (bf16_t)0x3f80 : (bf16_t)0; }
      __syncthreads();
      f32x4 hacc[8];
#pragma unroll
      for (int vt = 0; vt < 8; ++vt) hacc[vt] = zero4;
      const int lrow_me = 16 * wid + fr;
      for (int dir = 0; dir < 2; ++dir) {
        __syncthreads();
        if (tid < 128) { s_a[tid] = gates[(size_t)(r0 + tid) * 32 + 24 + dir * 4 + hm]; s_b[tid] = gates[(size_t)(r0 + tid) * 32 + 16 + dir * 4 + hm]; }
        __syncthreads();
        if (wid == 0) scan128_sum(s_a, s_cum, dir, lane);
        __syncthreads();
        if (tid < 128) s_a[tid] = s_b[tid] - s_cum[tid];
        __syncthreads();
        if (wid == 0) scan128_max(s_a, s_pm, dir, lane);
        const int cp = dir ? NCH - 1 - c : c;
        const size_t sidx = (size_t)((b * 4 + hm) * 2 + dir) * NCH + cp;
        for (int id = tid; id < 2304; id += 512) {
          const f32x4 v = *(const f32x4*)(mls + sidx * 9216 + id * 4);
          st_bf4(St + (id >> 4) * 72 + (id & 15) * 4, v);
        }
        const float mst = mlg[sidx * 3 + 2];
        __syncthreads();
        const float cl = s_cum[lrow_me];
        int lrow_v = lrow_me; asm volatile("" : "+v"(lrow_v));
        const float mrow = cl + fmaxf(s_pm[lrow_me], mst);
        const float winter = fexp(fminf(cl + mst - mrow, 0.f));
#pragma unroll 1
        for (int st = 0; st < 8; ++st) {
          f32x4 mv;
          const f32x4 s0_ = mma_lds(A1 + st * 16 * 72, 72, A0 + wid * 16 * 72, 72, 64, zero4, fr, fq);
#pragma unroll
          for (int j = 0; j < 4; ++j) {
            const int s = 16 * st + 4 * fq + j;
            const bool ok = dir ? (s >= lrow_v) : (s <= lrow_v);
            mv[j] = ok ? s0_[j] * fexp(fminf(cl + s_a[s] - mrow, 0.f)) : 0.f;
          }
          st_bf4(Ms + lrow_me * 136 + 16 * st + 4 * fq, mv);
        }
        __syncthreads();
        float dd;
        {
          const f32x4 a1 = mma_lds(Vt + 8 * 16 * 136, 136, Ms + wid * 16 * 136, 136, 128, zero4, fr, fq);
          const f32x4 a2 = mma_lds(St + 8 * 16 * 72, 72, A0 + wid * 16 * 72, 72, 64, zero4, fr, fq);
          const float den = __shfl(a1[0] + winter * a2[0], fr);
          dd = 1.f / fmaxf(fabsf(den), fexp(-mrow));
        }
#pragma unroll
        for (int vt = 0; vt < 8; ++vt) {
          const f32x4 a1 = mma_lds(Vt + vt * 16 * 136, 136, Ms + wid * 16 * 136, 136, 128, zero4, fr, fq);
          const f32x4 a2 = mma_lds(St + vt * 16 * 72, 72, A0 + wid * 16 * 72, 72, 64, zero4, fr, fq);
          hacc[vt] += (a1 + winter * a2) * dd;
        }
      }
      const int pp = c * 128 + lrow_me;
      if (pp >= PAD0) {
        const size_t r = (size_t)r0 + lrow_me;
#pragma unroll
        for (int vt = 0; vt < 8; ++vt) st_bf4(mixed + r * 2048 + 1536 + hm * 128 + vt * 16 + 4 * fq, hacc[vt]);
      }
    }
  }
  __syncthreads();
}


#ifndef DBGCHK
#define DBGCHK 0
#endif
#if DBGCHK
DI float blk_max(float v, float* red, int tid) {
  v = wmax(v); __syncthreads(); if ((tid & 63) == 0) red[tid >> 6] = v; __syncthreads();
  float r = red[0]; for (int i = 1; i < 8; ++i) r = fmaxf(r, red[i]); return r;
}
DI float blk_sum(float v, float* red, int tid) {
  v = wsum(v); __syncthreads(); if ((tid & 63) == 0) red[tid >> 6] = v; __syncthreads();
  float r = 0.f; for (int i = 0; i < 8; ++i) r += red[i]; return r;
}
DI void dbg_check_attn(PmK p, char* lds) {
  LAUNDER(p);
  const int tid = otid();
  float* w = (float*)lds; float* red = w + 8320;
  const int b = 1, j = 2, h = 1, pq = 5000;
  const bf16_t* base = (const bf16_t*)(p->ws + OFF_DQKV) + (size_t)b * TP * 1536;
  const bf16_t* mixed = (const bf16_t*)(p->ws + OFF_MIXED);
  float mx = NEGF;
  for (int t = PAD0 + tid; t < TP; t += 512) {
    float s = 0.f;
    for (int c = 0; c < 64; ++c) s += bf2f(base[(size_t)pq * 1536 + j * 64 + c]) * bf2f(base[(size_t)t * 1536 + 512 + j * 64 + c]);
    w[t] = s; mx = fmaxf(mx, s);
  }
  const float M = blk_max(mx, red, tid);
  float ls = 0.f;
  for (int t = PAD0 + tid; t < TP; t += 512) { const float e = __builtin_amdgcn_exp2f(w[t] - M); w[t] = e; ls += e; }
  const float L = blk_sum(ls, red, tid);
  __syncthreads();
  float err = 0.f, mag = 0.f;
  if (tid < 128) {
    float o = 0.f;
    for (int t = PAD0; t < TP; ++t) o += w[t] * bf2f(base[(size_t)t * 1536 + 1024 + h * 128 + tid]);
    o /= L;
    const float kv = bf2f(mixed[((size_t)b * TP + pq) * 2048 + 1024 + h * 128 + tid]);
    err = fabsf(o - kv); mag = fabsf(o);
  }
  const float E = blk_max(err, red, tid), G = blk_max(mag, red, tid);
  if (tid == 0) ((float*)(p->ws + OFF_SCAL))[8] = 1000.f + 1000.f * fminf(E / G, 50.f);
}

DI void dbg_check_p2x(PmK p, int l, char* lds) {
  LAUNDER(p);
  const int tid = otid();
  float* raw = (float*)lds; float* red = raw + 256;
  const int b = 1, pq = 5000, r = b * TP + pq;
  const bf16_t* hn = (const bf16_t*)(p->ws + OFF_HN); const bf16_t* win = (const bf16_t*)(p->ws + OFF_WIN);
  const bf16_t* dqkv = (const bf16_t*)(p->ws + OFF_DQKV);
  float err = 0.f, mag = 0.f;
  for (int hsel = 0; hsel < 2; ++hsel) {
    const int hd = hsel ? 19 : 17;
    __syncthreads();
    if (tid < 64) { float a = 0.f; for (int k = 0; k < 1024; ++k) a += bf2f(hn[(size_t)r * 1024 + k]) * bf2f(win[(size_t)(672 + hd * 64 + tid) * 1024 + k]); raw[tid] = a; }
    __syncthreads();
    if (tid < 64) {
      float ss = 0.f; for (int c = 0; c < 64; ++c) ss += raw[c] * raw[c];
      const float rinv = rsqrtf(ss / 64.f + 1e-6f) * (hd < 8 ? 0.125f * LOG2E : 1.f);
      const float* g = (hd < 8 ? p->dq_g : p->dk_g) + l * 64; if (hd >= 16) g = p->dq_g;
      auto nv = [&](int c) { return raw[c] * rinv * g[c]; };
      float o = nv(tid);
      if (tid < 16) { const int i = tid & 7; float cs, sn; sincos_rev((float)(pq - PAD0) * p->inv_d[i], cs, sn);
        o = tid < 8 ? nv(tid) * cs - nv(tid + 8) * sn : nv(tid) * cs + nv(tid - 8) * sn; }
      const float kv = bf2f(dqkv[(size_t)r * 1536 + hd * 64 + tid]);
      if (hd >= 16) o = raw[tid];
      err = fmaxf(err, fabsf(o - kv)); mag = fmaxf(mag, fabsf(o));
    }
  }
  const float E = blk_max(err, red, tid), G = blk_max(mag, red, tid);
  if (tid == 0) ((float*)(p->ws + OFF_SCAL))[8] = 1000.f + 1000.f * fminf(E / G, 50.f);
}
#endif
#define EPI_WRAP(name, f) auto name = [=](const f32x4 (&acc)[2][2][4][2], int pm, int pn, int wr, int wc, int fr, int fq) { epi_each(acc, pm, pn, wr, wc, fr, fq, f); }
__global__ void __launch_bounds__(512) mega(Pm p_unused) {
  PmK p = (PmK)__builtin_amdgcn_kernarg_segment_ptr();
  char* const lds = g_lds;
  cg::grid_group grid = cg::this_grid();
  { const int t0 = threadIdx.x; const int key = __builtin_amdgcn_s_getreg(10244) & 63;
    if ((t0 & 63) == 0) ((volatile int*)(g_lds + WID_TAB_OFF))[key] = t0 >> 6;
    if (t0 < 4) ((volatile int*)(g_lds + WID_TAB_OFF + 512))[t0] = 0;
    __syncthreads(); }
  (void)xcd_barrier_post((unsigned*)(p->ws + OFF_BAR), (volatile LAS unsigned*)(g_lds + WID_TAB_OFF + 512), threadIdx.x == 0);
  const int lo = p->ph0, hi = p->ph1;
#define IN(k) ((ONLY < 0 || ONLY == (k)) && lo <= l * NPH + (k) && l * NPH + (k) < hi)
#define SEAM(k) do { if (l * NPH + (k) + 1 < hi) { if (l == 0 && (k) == 0) grid.sync(); else seam_barrier(p); } } while (0)
#pragma unroll
  for (int l = 0; l < 2; ++l) {
    if (IN(0)) { LAUNDER(p); char* const ws = p->ws; (void)ws; phase_prep(p, l, lds); if (DUP & 8) phase_prep(p, l, lds); SEAM(0); }
    if (IN(1)) { LAUNDER(p); char* const ws = p->ws; (void)ws;
      bf16_t* pa = (bf16_t*)(ws + OFF_PA); bf16_t* dqkv = (bf16_t*)(ws + OFF_DQKV);
      auto f = [=](int row, int col, f32x4 v0, f32x4 v1) {
        if (col < 672) st_bf8v(pa + (size_t)row * 672 + col, v0, v1);
        else if (col < 2208) st_bf8v(dqkv + (size_t)row * 1536 + (col - 672), v0, v1);
      };
      auto epi = [=](const f32x4 (&acc)[2][2][4][2], int pm, int pn, int wr, int wc, int fr, int fq) { epi_each8(acc, pm, pn, wr, wc, fr, fq, f); };
      gemm_fast_p(lds, (const bf16_t*)(ws + OFF_HN), 1024, (const bf16_t*)(ws + OFF_WIN), 1024, R / 256, XW / 256, 1024, epi);
      SEAM(1);
    }
    if (IN(2)) { LAUNDER(p); char* const ws = p->ws; (void)ws;
      bf16_t* mq = (bf16_t*)(ws + OFF_MQ); bf16_t* knr = (bf16_t*)(ws + OFF_KNR); bf16_t* mv = (bf16_t*)(ws + OFF_MVR);
      auto fq_ = [=](int row, int col, f32x4 v0, f32x4 v1) { st_bf8v(mq + (size_t)row * 768 + col, v0, v1); };
      auto epiq = [=](const f32x4 (&acc)[2][2][4][2], int pm, int pn, int wr, int wc, int fr, int fq) { epi_each8(acc, pm, pn, wr, wc, fr, fq, fq_); };
      gemm_fast_p(lds, (const bf16_t*)(ws + OFF_PA), 672, (const bf16_t*)(ws + OFF_WUQ), 384, R / 256, 3, 384, epiq);
      auto fkv = [=](int row, int col, f32x4 v0, f32x4 v1) {
        const int hh = col >> 7, c = col & 127;
        if (c < 64) st_bf8v(knr + (size_t)row * 512 + hh * 64 + c, v0, v1); else st_bf8v(mv + (size_t)row * 512 + hh * 64 + (c - 64), v0, v1);
      };
      auto epikv = [=](const f32x4 (&acc)[2][2][4][2], int pm, int pn, int wr, int wc, int fr, int fq) { epi_each8(acc, pm, pn, wr, wc, fr, fq, fkv); };
      gemm_fast_p(lds, (const bf16_t*)(ws + OFF_PA) + 384, 672, (const bf16_t*)(ws + OFF_WUKV), 256, R / 256, 4, 256, epikv);
      SEAM(2);
    }
    if (IN(3)) { LAUNDER(p); char* const ws = p->ws; (void)ws; phase_p3(p, l, lds); phase_p2x(p, l); vtrans_items(p, lds); SEAM(3); }
    if (IN(4)) { LAUNDER(p); char* const ws = p->ws; (void)ws; for (int rep = 0; rep < ((DUP & 2) ? 2 : 1); ++rep) phase_attn(p, lds, rep); SEAM(4); }
    if (IN(5)) { LAUNDER(p); char* const ws = p->ws; (void)ws;
      bf16_t* sz = (bf16_t*)(ws + OFF_SZ); bf16_t* xr = (bf16_t*)(ws + OFF_XBCR); bf16_t* mo = (bf16_t*)(ws + OFF_MQKVO); float* gates = (float*)(ws + OFF_GATES);
      auto f = [=](int row, int col, f32x4 v0, f32x4 v1) {
        if (col < 512) st_bf8v(sz + (size_t)row * 512 + col, v0, v1);
        else if (col < 1280) st_bf8v(xr + (size_t)row * 768 + (col - 512), v0, v1);
        else if (col < 2816) st_bf8v(mo + (size_t)row * 1536 + (col - 1280), v0, v1);
        else if (col < 2848) { float* gp = gates + (size_t)row * 32 + (col - 2816); *(f32x4*)gp = v0; *(f32x4*)(gp + 4) = v1; }
      };
      auto epi = [=](const f32x4 (&acc)[2][2][4][2], int pm, int pn, int wr, int wc, int fr, int fq) { epi_each8(acc, pm, pn, wr, wc, fr, fq, f); };
      gemm_fast_p(lds, (const bf16_t*)(ws + OFF_HN), 1024, (const bf16_t*)(ws + OFF_WIN) + (size_t)XW * 1024, 1024, R / 256, YW / 256, 1024, epi);
      SEAM(5);
    }
    if (IN(6)) { LAUNDER(p); char* const ws = p->ws; (void)ws; phase_p2y(p, l); SEAM(6); }
    if (IN(7)) { LAUNDER(p); char* const ws = p->ws; (void)ws; phase_states(p, l, lds); if (DUP & 4) phase_states(p, l, lds); SEAM(7); }
    if (IN(8)) { LAUNDER(p); char* const ws = p->ws; (void)ws; phase_scan(p); SEAM(8); }
    if (IN(9)) { LAUNDER(p); char* const ws = p->ws; (void)ws; phase_out(p, l, lds); if (DUP & 4) phase_out(p, l, lds); SEAM(9); }
    if (IN(10)) { LAUNDER(p); char* const ws = p->ws; (void)ws; phase_post(p, l); SEAM(10); }
    if (IN(11)) { LAUNDER(p); char* const ws = p->ws; (void)ws;
      float* const outp = p->out; float* const metah = (float*)(ws + OFF_METAH);
      auto f = [=](int row, int col, f32x4 v) { float* hr = hrow2(outp, metah, row); if (hr) { f32x4* d = (f32x4*)(hr + col); *d = *d + v; } };
      EPI_WRAP(epi, f);
      gemm_fast(lds, (const bf16_t*)(ws + OFF_MIXED), 2048, (const bf16_t*)(ws + OFF_WOUT), 2048, R / 256, 4, 2048, epi);
      SEAM(11);
    }
    if (IN(12)) { LAUNDER(p); char* const ws = p->ws; (void)ws; norm_rows(p, false); SEAM(12); }
    if (IN(13)) { LAUNDER(p); char* const ws = p->ws; (void)ws;
      bf16_t* act = (bf16_t*)(ws + OFF_ACT);
      auto epi = [=](const f32x4 (&acc)[2][2][4][2], int pm, int pn, int wr, int wc, int fr, int fq) {
#pragma unroll
        for (int ai = 0; ai < 2; ++ai)
#pragma unroll
          for (int m = 0; m < 4; ++m) {
            const int row = pm * 256 + 128 * ai + 64 * wr + 16 * m + fr;
            f32x4 a[2];
#pragma unroll
            for (int n = 0; n < 2; ++n) {
              const f32x4 g = acc[ai][0][m][n], u = acc[ai][1][m][n];
              a[n][0] = siluf(g[0]) * u[0]; a[n][1] = siluf(g[1]) * u[1]; a[n][2] = siluf(g[2]) * u[2]; a[n][3] = siluf(g[3]) * u[3];
            }
            st_bf8v(act + (size_t)row * 2816 + pn * 128 + 32 * wc + 8 * fq, a[0], a[1]);
          }
      };
      gemm_fast_p(lds, (const bf16_t*)(ws + OFF_HN), 1024, (const bf16_t*)(ws + OFF_WFI), 1024, R / 256, 22, 1024, epi);
      if (DUP & 1) gemm_fast_p(lds, (const bf16_t*)(ws + OFF_HN), 1024, (const bf16_t*)(ws + OFF_WFI), 1024, R / 256, 22, 1024, epi);
      SEAM(13);
    }
    if (IN(14)) { LAUNDER(p); char* const ws = p->ws; (void)ws;
      float* const outp = p->out; float* const metah = (float*)(ws + OFF_METAH);
      auto f = [=](int row, int col, f32x4 v) { float* hr = hrow2(outp, metah, row); if (hr) { f32x4* d = (f32x4*)(hr + col); *d = *d + v; } };
      EPI_WRAP(epi, f);
      gemm_fast(lds, (const bf16_t*)(ws + OFF_ACT), 2816, (const bf16_t*)(ws + OFF_WFO), 2816, R / 256, 4, 2816, epi);
      SEAM(14);
    }
  }
#undef IN
#undef SEAM
#if DBGCHK
  grid.sync();
  if (blockIdx.x == 0) dbg_check_p2x(p, 0, lds);
  grid.sync();
  { float* o = p->out; const float code = ((const float*)(p->ws + OFF_SCAL))[8];
    for (size_t i = (size_t)blockIdx.x * 512 + threadIdx.x; i < (size_t)4 * 8192 * 1024; i += (size_t)gridDim.x * 512) o[i] = i == 0 ? code : 0.f; }
#endif
}

__global__ void __launch_bounds__(512) dbg_hash(const unsigned* ws, size_t nwords, float* out) {
  const size_t gt = (size_t)blockIdx.x * 512 + threadIdx.x, gn = (size_t)gridDim.x * 512;
  unsigned h = 0;
  for (size_t i = gt; i < nwords; i += gn) h = h * 31u + ws[i];
  out[gt] = (float)(h & 0xFFFFFu);
}
constexpr size_t LDS_BYTES = 140 * 1024;
extern "C" void kernel_launch(void* const* d_in, const int* in_sizes, int n_in, void* d_out, int out_size, void* d_ws, size_t ws_size, hipStream_t stream) {
  static int grid_blocks = 0;
  if (!grid_blocks) {
    if (ws_size < WS_NEED) { fprintf(stderr, "kernel_launch: workspace too small: %zu < %zu\n", ws_size, WS_NEED); return; }
    if (hipFuncSetAttribute((const void*)mega, hipFuncAttributeMaxDynamicSharedMemorySize, (int)LDS_BYTES) != hipSuccess) { fprintf(stderr, "kernel_launch: LDS attribute failed\n"); return; }
    int dev = 0, cus = 0, per_cu = 0;
    hipGetDevice(&dev);
    hipDeviceGetAttribute(&cus, hipDeviceAttributeMultiprocessorCount, dev);
    hipOccupancyMaxActiveBlocksPerMultiprocessor(&per_cu, mega, 512, LDS_BYTES);
    if (per_cu < 1) { fprintf(stderr, "kernel_launch: occupancy 0\n"); return; }
    grid_blocks = cus * 1;
  }
  Pm p;
  memset(&p, 0, sizeof(p));
  const float** fp = (const float**)&p;
  for (int i = 0; i < 28; ++i) fp[i] = (const float*)d_in[i];
  p.out = (float*)d_out; p.ws = (char*)d_ws;
  for (int i = 0; i < 16; ++i) p.inv_m[i] = 1.0f / powf(500000.0f, (float)(2 * i) / 32.0f);
  for (int i = 0; i < 8; ++i) p.inv_d[i] = 1.0f / powf(500000.0f, (float)(2 * i) / 16.0f);
  for (int l = 0; l < 2; ++l) p.linit[l] = (float)(0.8 - 0.6 * exp(-0.3 * l));
  hipMemsetAsync((char*)d_ws + OFF_BAR, 0, 16384, stream);
#if MULTI
  for (int ph = 0; ph < DBG_NPH; ++ph) {
    p.ph0 = ph; p.ph1 = ph + 1;
    hipLaunchKernelGGL(mega, dim3(grid_blocks), dim3(512), LDS_BYTES, stream, p);
  }
#else
  p.ph0 = 0; p.ph1 = DBGCHK ? 5 : 2 * NPH;
  void* args[] = {&p};
  hipError_t e = hipLaunchCooperativeKernel((void*)mega, dim3(grid_blocks), dim3(512), args, LDS_BYTES, stream);
  if (e != hipSuccess) fprintf(stderr, "cooperative launch failed: %s (grid %d)\n", hipGetErrorString(e), grid_blocks);
#endif
}
```

```cpp
#include <hip/hip_runtime.h>
#include <hip/hip_cooperative_groups.h>
#include <cstdio>
#include <cmath>
#include <cstring>
namespace cg = cooperative_groups;

typedef unsigned short bf16_t;
typedef short bf16x8 __attribute__((ext_vector_type(8)));
typedef float f32x4 __attribute__((ext_vector_type(4)));
typedef unsigned u32x4 __attribute__((ext_vector_type(4)));
#define DI __device__ __forceinline__
#define MFMA16(a, b, c) __builtin_amdgcn_mfma_f32_16x16x32_bf16((a), (b), (c), 0, 0, 0)

#ifndef MULTI
#define MULTI 0
#endif
#ifndef DBG_NPH
#define DBG_NPH (2 * NPH)
#endif
#ifndef ZB
#define ZB -1
#endif
#ifndef DUP
#define DUP 0
#endif
#ifndef ONLY
#define ONLY -1
#endif

constexpr int NB = 4, TP = 8320, R = NB * TP, NCH = 65, PAD0 = 112;
constexpr int XW = 2304, YW = 3072;
constexpr int NPH = 15;
constexpr float NEGF = -1e30f;
constexpr float LOG2E = 1.4426950408889634f;

constexpr size_t al256(size_t x) { return (x + 255) & ~size_t(255); }
constexpr size_t SZ_WIN = (size_t)(XW + YW) * 1024 * 2, SZ_WUQ = (size_t)768 * 384 * 2, SZ_WUKV = (size_t)1024 * 256 * 2,
                 SZ_WOUT = (size_t)1024 * 2048 * 2, SZ_WFI = (size_t)5632 * 1024 * 2, SZ_WFO = (size_t)1024 * 2816 * 2;
constexpr size_t OFF_WIN = 0, OFF_WUQ = OFF_WIN + al256(SZ_WIN), OFF_WUKV = OFF_WUQ + al256(SZ_WUQ), OFF_WOUT = OFF_WUKV + al256(SZ_WUKV),
                 OFF_WFI = OFF_WOUT + al256(SZ_WOUT), OFF_WFO = OFF_WFI + al256(SZ_WFI), OFF_METAH = OFF_WFO + al256(SZ_WFO),
                 OFF_SCAL = OFF_METAH + al256((size_t)64 * 1024 * 4), OFF_SSDD = OFF_SCAL + 256,
                 OFF_MLG = OFF_SSDD + al256((size_t)64 * NCH * 4), OFF_BAR = OFF_MLG + al256((size_t)32 * NCH * 3 * 4), OFF_HN = OFF_BAR + 16384;
constexpr size_t SZ_HN = (size_t)R * 1024 * 2;
constexpr size_t OFF_SSDS = OFF_HN;
constexpr size_t OFF_MIXED = OFF_HN + al256(SZ_HN);
constexpr size_t SZ_MIXED = (size_t)R * 2048 * 2;
constexpr size_t OFF_PA = OFF_MIXED, OFF_KNR = OFF_PA + al256((size_t)R * 672 * 2), OFF_MVR = OFF_KNR + al256((size_t)R * 512 * 2);
constexpr size_t OFF_U = OFF_MIXED + al256(SZ_MIXED);
constexpr size_t OFF_DQKV = OFF_U, OFF_MQ = OFF_DQKV + al256((size_t)R * 1536 * 2), OFF_MK = OFF_MQ + al256((size_t)R * 768 * 2),
                 OFF_MVT = OFF_MK + al256((size_t)R * 768 * 2), OFF_DVT = OFF_MVT + al256((size_t)R * 512 * 2), END_X = OFF_DVT + al256((size_t)R * 512 * 2);
constexpr size_t OFF_SZ = OFF_U, OFF_XBCC = OFF_SZ + al256((size_t)R * 512 * 2), OFF_MQKVO = OFF_XBCC + al256((size_t)R * 768 * 2),
                 OFF_GATES = OFF_MQKVO + al256((size_t)R * 1536 * 2), OFF_MLS = OFF_GATES + al256((size_t)R * 32 * 4),
                 END_Y = OFF_MLS + al256((size_t)32 * NCH * 9216 * 4);
constexpr size_t OFF_XBCR = OFF_MLS;
constexpr size_t OFF_ACT = OFF_U, END_F = OFF_ACT + al256((size_t)R * 2816 * 2);
constexpr size_t WS_NEED = (END_X > END_Y ? (END_X > END_F ? END_X : END_F) : (END_Y > END_F ? END_Y : END_F));
static_assert(SZ_HN == (size_t)64 * NCH * 4096 * 4, "ssd states alias hn");
static_assert(OFF_MVR + (size_t)R * 512 * 2 <= OFF_U, "transients fit in mixed");
static_assert((size_t)R * 768 * 2 <= (size_t)32 * NCH * 9216 * 4, "xbc raw fits in mlstm states");

struct Pm {
  const float *x, *meta, *attn_g, *w_in, *q_norm_g, *kv_norm_g, *w_uq, *w_ukv, *q_head_g, *k_head_g, *mla_out_g, *conv_w, *conv_b,
      *dt_bias, *a_log, *ssd_d, *ssd_norm_g, *dq_g, *dk_g, *dlam, *dout_g, *i_bias, *f_bias, *ml_out_g, *w_out, *ffn_g, *w_fi, *w_fo;
  float* out;
  char* ws;
  float inv_m[16];
  float inv_d[8];
  float linit[2];
  int ph0, ph1;
};

typedef const Pm __attribute__((address_space(4)))* PmK;
#define LAUNDER(p) asm volatile("" : "+s"(p))
extern __shared__ __attribute__((aligned(16))) char g_lds[];
constexpr int WID_TAB_OFF = 139 * 1024;
DI int otid() {
  const int key = __builtin_amdgcn_s_getreg(10244) & 63;
  const int wv = __builtin_amdgcn_readfirstlane(((volatile int*)(g_lds + WID_TAB_OFF))[key]);
  unsigned ones = ~0u; asm volatile("" : "+s"(ones));
  int t = wv * 64 + (int)__builtin_amdgcn_mbcnt_hi(ones, __builtin_amdgcn_mbcnt_lo(ones, 0u));
  asm volatile("" : "+v"(t));
  return t;
}
typedef __bf16 bf2_t __attribute__((ext_vector_type(2)));
typedef float f32x2 __attribute__((ext_vector_type(2)));
DI unsigned cvt_pk(float lo, float hi) { f32x2 v = {lo, hi}; bf2_t b = __builtin_convertvector(v, bf2_t); return __builtin_bit_cast(unsigned, b); }
DI bf16_t f2bf(float x) { return (bf16_t)(cvt_pk(x, 0.f) & 0xffffu); }
DI float bf2f(bf16_t b) { return __uint_as_float(((unsigned)b) << 16); }
DI float bflo(unsigned w) { return __uint_as_float(w << 16); }
DI float bfhi(unsigned w) { return __uint_as_float(w & 0xffff0000u); }
DI void st_bf4(bf16_t* dst, f32x4 v) { uint2 w; w.x = cvt_pk(v[0], v[1]); w.y = cvt_pk(v[2], v[3]); *(uint2*)dst = w; }
DI f32x4 ld_bf4(const bf16_t* src) { uint2 w = *(const uint2*)src; f32x4 v; v[0] = bflo(w.x); v[1] = bfhi(w.x); v[2] = bflo(w.y); v[3] = bfhi(w.y); return v; }
DI void ld_bf8(const bf16_t* src, float* v) { uint4 w = *(const uint4*)src; v[0] = bflo(w.x); v[1] = bfhi(w.x); v[2] = bflo(w.y); v[3] = bfhi(w.y); v[4] = bflo(w.z); v[5] = bfhi(w.z); v[6] = bflo(w.w); v[7] = bfhi(w.w); }
DI void st_bf8(bf16_t* dst, const float* v) { uint4 w; w.x = cvt_pk(v[0], v[1]); w.y = cvt_pk(v[2], v[3]); w.z = cvt_pk(v[4], v[5]); w.w = cvt_pk(v[6], v[7]); *(uint4*)dst = w; }
DI float wsum(float v) { for (int m = 32; m >= 1; m >>= 1) v += __shfl_xor(v, m); return v; }
DI float wmax(float v) { for (int m = 32; m >= 1; m >>= 1) v = fmaxf(v, __shfl_xor(v, m)); return v; }
DI float fexp(float x) { return __builtin_amdgcn_exp2f(x * LOG2E); }
DI float siluf(float x) { return x * __builtin_amdgcn_rcpf(1.f + fexp(-x)); }
DI float sigmf(float x) { return __builtin_amdgcn_rcpf(1.f + fexp(-x)); }
DI float softplusf(float x) { const float e = fexp(x); return x > 20.f ? x : (x < -4.f ? e * (1.f - 0.5f * e + 0.33333334f * e * e) : 0.6931471805599453f * __builtin_amdgcn_logf(1.f + e)); }
DI float* hrow2(float* out, float* metah, int r) {
  const int b = r / TP, pp = r - b * TP;
  if (pp < PAD0) return nullptr;
  if (pp < 128) return metah + (size_t)(b * 16 + pp - PAD0) * 1024;
  return out + ((size_t)b * 8192 + pp - 128) * 1024;
}
DI float* hrow(PmK p, int r) { return hrow2(p->out, (float*)(p->ws + OFF_METAH), r); }
DI void sincos_rev(float ang, float& c, float& s) {
  double rev = (double)ang * 0.15915494309189535; rev -= rint(rev); const float f = (float)rev;
  s = __builtin_amdgcn_sinf(f); c = __builtin_amdgcn_cosf(f);
}
DI f32x4 mma_lds(const bf16_t* X, int ldx, const bf16_t* Y, int ldy, int K, f32x4 acc, int fr, int fq) {
  for (int k0 = 0; k0 < K; k0 += 32) {
    const bf16x8 x = *(const bf16x8*)(X + fr * ldx + k0 + fq * 8), y = *(const bf16x8*)(Y + fr * ldy + k0 + fq * 8);
    acc = MFMA16(x, y, acc);
  }
  __builtin_amdgcn_sched_barrier(0);
  return acc;
}
DI void scan128_sum(const float* v, float* cum, int dir, int lane) {
  const int i0 = 2 * lane, n0 = dir ? 127 - i0 : i0, n1 = dir ? 126 - i0 : i0 + 1;
  const float a = v[n0], b = a + v[n1]; float s = b;
  for (int d = 1; d < 64; d <<= 1) { const float t = __shfl_up(s, d); if (lane >= d) s += t; }
  const float ex = s - b; cum[n0] = ex + a; cum[n1] = ex + b;
}
DI void scan128_max(const float* v, float* cum, int dir, int lane) {
  const int i0 = 2 * lane, n0 = dir ? 127 - i0 : i0, n1 = dir ? 126 - i0 : i0 + 1;
  const float a = v[n0], b = fmaxf(a, v[n1]); float s = b;
  for (int d = 1; d < 64; d <<= 1) { const float t = __shfl_up(s, d); if (lane >= d) s = fmaxf(s, t); }
  float ex = __shfl_up(s, 1); if (lane == 0) ex = NEGF * 3.f;
  cum[n0] = fmaxf(ex, a); cum[n1] = fmaxf(ex, b);
}

#define XB_TMO      128
#define XB_XCNT(j)  (256  + 64 * (j))
#define XB_XSUB(j)  (1280 + 64 * (j))
#define XB_XGEN(j)  (2304 + 64 * (j))
#define XB_TOP      3328
#define XB_TOPGEN   3392
#define XCD_BAR_WORDS 3456
#define XB_SPIN_CAP (1u << 18)
#define LAS __attribute__((address_space(3)))

__device__ __forceinline__ unsigned xb_ld(unsigned* p)              { return __hip_atomic_load(p, __ATOMIC_RELAXED, __HIP_MEMORY_SCOPE_AGENT); }
__device__ __forceinline__ unsigned xb_add(unsigned* p, unsigned v) { return __hip_atomic_fetch_add(p, v, __ATOMIC_RELAXED, __HIP_MEMORY_SCOPE_AGENT); }
__device__ __forceinline__ unsigned xb_xcc_id() { return (unsigned)__builtin_amdgcn_s_getreg((3 << 11) | 20) & 0xFu; }
#define XB_SPIN(cond, bar) do { unsigned _sp = 0; while (cond) { __builtin_amdgcn_s_sleep(1); \
    if ((++_sp & 255u) == 0u) { if (xb_ld(&(bar)[XB_TMO])) break; if (_sp > XB_SPIN_CAP) { atomicAdd(&(bar)[XB_TMO], 1u); break; } } } } while (0)

struct XcdBarrier {
    unsigned* bar; unsigned x;
    volatile LAS unsigned* st;
};

__device__ __forceinline__ XcdBarrier xcd_barrier_post(unsigned* bar, volatile LAS unsigned* st, bool xb_tid0) {
    XcdBarrier b; b.bar = bar; b.x = xb_xcc_id(); b.st = st;
    if (xb_tid0) (void)xb_add(&bar[XB_XCNT(b.x)], 1u);
    return b;
}
__device__ __forceinline__ void xcd_barrier_complete(unsigned* bar, unsigned x, unsigned& nloc, unsigned& nx) {
    const unsigned G = gridDim.x * gridDim.y * gridDim.z;
    unsigned sum, cnt, mine, sp = 0u;
    for (;;) {
        sum = 0u; cnt = 0u; mine = 0u;
#pragma unroll
        for (unsigned j = 0; j < 16; ++j) { const unsigned c = xb_ld(&bar[XB_XCNT(j)]); sum += c; cnt += (c > 0u) ? 1u : 0u; mine = (j == x) ? c : mine; }
        if (sum == G) break;
        __builtin_amdgcn_s_sleep(1);
        if ((++sp & 255u) == 0u) { if (xb_ld(&bar[XB_TMO])) break; if (sp > XB_SPIN_CAP) { atomicAdd(&bar[XB_TMO], 1u); break; } }
    }
    nloc = mine > 0u ? mine : 1u; nx = cnt > 0u ? cnt : 1u;
}

__device__ __forceinline__ void xcd_barrier(const XcdBarrier& b) {
    const bool xb_tid0 = otid() == 0;
    asm volatile("s_waitcnt vmcnt(0)" ::: "memory");
    __syncthreads();
    if (xb_tid0) {
        unsigned* bar = b.bar;
        __builtin_amdgcn_s_waitcnt(0);
        unsigned nloc = b.st[0], nx = b.st[1];
        if (nloc == 0u) { xcd_barrier_complete(bar, b.x, nloc, nx); b.st[0] = nloc; b.st[1] = nx; }
        const unsigned old = xb_add(&bar[XB_XSUB(b.x)], 1u);
        const unsigned gen = old / nloc;
        if (old + 1u == (gen + 1u) * nloc) {
            __builtin_amdgcn_fence(__ATOMIC_RELEASE, "agent");
            asm volatile("s_waitcnt vmcnt(0)" ::: "memory");
            const unsigned og = xb_add(&bar[XB_TOP], 1u);
            const unsigned tg = og / nx;
            if (og + 1u == (tg + 1u) * nx) xb_add(&bar[XB_TOPGEN], 1u);
            else XB_SPIN(xb_ld(&bar[XB_TOPGEN]) == tg, bar);
            __builtin_amdgcn_fence(__ATOMIC_ACQUIRE, "agent");
            xb_add(&bar[XB_XGEN(b.x)], 1u);
            asm volatile("s_waitcnt vmcnt(0)" ::: "memory");
        } else {
            XB_SPIN(xb_ld(&bar[XB_XGEN(b.x)]) == gen, bar);
            __builtin_amdgcn_fence(__ATOMIC_ACQUIRE, "agent");
            asm volatile("s_waitcnt vmcnt(0)" ::: "memory");
        }
    }
    __syncthreads();
}


DI void seam_barrier(PmK p) {
  LAUNDER(p);
  XcdBarrier b; b.bar = (unsigned*)(p->ws + OFF_BAR); b.x = xb_xcc_id(); b.st = (volatile LAS unsigned*)(g_lds + WID_TAB_OFF + 512);
  xcd_barrier(b);
}

DI int map_in(int n) {
  if (n < 672) return n;
  if (n < 1184) return XW + (n - 672);
  if (n < 1952) return XW + 512 + (n - 1184);
  if (n < 1968) return XW + 2816 + (n - 1952);
  if (n < 3504) return 672 + (n - 1968);
  if (n < 5040) return XW + 1280 + (n - 3504);
  return XW + 2832 + (n - 5040);
}
DI int map_fi(int n) { const int half = n >= 2816, j = n - half * 2816; return 256 * (j >> 7) + half * 128 + (j & 127); }
template <int MODE>
DI void wtrans(char* lds, const float* __restrict__ W, int K, int N, const float* __restrict__ g, bf16_t* __restrict__ Wt) {
  float* tl = (float*)lds;
  const int tid = otid(), nkt = K / 64, nnt = N / 64;
  for (int t = blockIdx.x; t < nkt * nnt; t += gridDim.x) {
    const int kt = t % nkt, nt = t / nkt;
    __syncthreads();
#pragma unroll
    for (int i = 0; i < 8; ++i) {
      const int k = (tid >> 6) + 8 * i, n = tid & 63;
      float v = W[(size_t)(kt * 64 + k) * N + nt * 64 + n];
      if (g) v *= g[kt * 64 + k];
      tl[k * 65 + n] = v;
    }
    __syncthreads();
#pragma unroll
    for (int i = 0; i < 8; ++i) {
      const int n = (tid >> 6) + 8 * i, k = tid & 63, gn = nt * 64 + n;
      const int dst = MODE == 1 ? map_in(gn) : MODE == 2 ? map_fi(gn) : gn;
      Wt[(size_t)dst * K + kt * 64 + k] = f2bf(tl[k * 65 + n]);
    }
  }
}

DI void norm_rows(PmK p, bool first) {
  LAUNDER(p);
  const int tid_ = otid(), wid = tid_ >> 6, lane = tid_ & 63;
  bf16_t* hn = (bf16_t*)(p->ws + OFF_HN);
  for (int r = blockIdx.x * 8 + wid; r < R; r += gridDim.x * 8) {
    const int b = r / TP, pp = r - b * TP;
    bf16_t* dst = hn + (size_t)r * 1024;
    if (pp < PAD0) {
      unsigned zz = 0u; asm volatile("" : "+v"(zz)); const uint4 z = {zz, zz, zz, zz};
      *(uint4*)(dst + lane * 16) = z; *(uint4*)(dst + lane * 16 + 8) = z;
      continue;
    }
    float* hr = hrow(p, r);
    const float* src = first ? (pp < 128 ? p->meta + (size_t)(pp - PAD0) * 1024 : p->x + ((size_t)b * 8192 + pp - 128) * 1024) : hr;
    f32x4 v[4]; float ss = 0.f;
#pragma unroll
    for (int i = 0; i < 4; ++i) { v[i] = *(const f32x4*)(src + i * 256 + lane * 4); ss += v[i][0] * v[i][0] + v[i][1] * v[i][1] + v[i][2] * v[i][2] + v[i][3] * v[i][3]; }
    ss = wsum(ss);
    const float rinv = rsqrtf(ss * (1.f / 1024.f) + 1e-6f);
#pragma unroll
    for (int i = 0; i < 4; ++i) {
      st_bf4(dst + i * 256 + lane * 4, v[i] * rinv);
    }
  }
}

DI void phase_prep(PmK p, int l, char* lds) {
  LAUNDER(p);
  char* ws = p->ws;
  wtrans<1>(lds, p->w_in + (size_t)l * 1024 * 5056, 1024, 5056, p->attn_g + l * 1024, (bf16_t*)(ws + OFF_WIN));
  wtrans<0>(lds, p->w_uq + (size_t)l * 384 * 768, 384, 768, p->q_norm_g + l * 384, (bf16_t*)(ws + OFF_WUQ));
  wtrans<0>(lds, p->w_ukv + (size_t)l * 256 * 1024, 256, 1024, p->kv_norm_g + l * 256, (bf16_t*)(ws + OFF_WUKV));
  wtrans<0>(lds, p->w_out + (size_t)l * 2048 * 1024, 2048, 1024, nullptr, (bf16_t*)(ws + OFF_WOUT));
  wtrans<2>(lds, p->w_fi + (size_t)l * 1024 * 5632, 1024, 5632, p->ffn_g + l * 1024, (bf16_t*)(ws + OFF_WFI));
  wtrans<0>(lds, p->w_fo + (size_t)l * 2816 * 1024, 2816, 1024, nullptr, (bf16_t*)(ws + OFF_WFO));
  bf16_t* win = (bf16_t*)(ws + OFF_WIN);
  const int tidp = otid();
  for (int i = blockIdx.x * 512 + tidp; i < (96 + 224) * 1024; i += gridDim.x * 512) {
    const int row = i >> 10, k = i & 1023;
    const int dst = row < 96 ? 2208 + row : XW + 2848 + (row - 96);
    win[(size_t)dst * 1024 + k] = 0;
  }
  if (blockIdx.x == 0 && tidp < 64) {
    const float* lam = p->dlam + l * 256; const int t = tidp;
    const float s1 = wsum(lam[t] * lam[64 + t]), s2 = wsum(lam[128 + t] * lam[192 + t]);
    if (t == 0) { float* sc = (float*)(p->ws + OFF_SCAL); asm volatile("" : "+s"(sc)); sc[0] = expf(s1) - expf(s2) + p->linit[l]; int z0 = 0; asm volatile("" : "+v"(z0)); ((int*)sc)[16] = z0; ((int*)sc)[17] = z0; ((int*)sc)[18] = z0; ((int*)sc)[19] = z0; }
  }
  norm_rows(p, l == 0);
}

template <class Epi>
DI void gemm_simple(char* lds, const bf16_t* __restrict__ A, int lda, const bf16_t* __restrict__ Bt, int ldb, int nM, int nN, int K, const Epi& epi) {
  const int tid = otid(), wid = tid >> 6, lane = tid & 63, wr = wid >> 2, wc = wid & 3, fr = lane & 15, fq = lane >> 4;
  bf16_t* As = (bf16_t*)lds; bf16_t* Bs = As + 256 * 72;
  for (int tile = blockIdx.x; tile < nM * nN; tile += gridDim.x) {
    const int pm = tile / nN, pn = tile - pm * nN;
    f32x4 acc[2][2][4][2];
#pragma unroll
    for (int a = 0; a < 2; ++a)
#pragma unroll
      for (int b = 0; b < 2; ++b)
#pragma unroll
        for (int m = 0; m < 4; ++m)
#pragma unroll
          for (int n = 0; n < 2; ++n) acc[a][b][m][n] = (f32x4){0.f, 0.f, 0.f, 0.f};
    const bf16_t* Ab = A + (size_t)pm * 256 * lda + (size_t)(tid >> 3) * lda + (tid & 7) * 8;
    const bf16_t* Bb = Bt + (size_t)pn * 256 * ldb + (size_t)(tid >> 3) * ldb + (tid & 7) * 8;
    bf16_t* const Asw = As + (tid >> 3) * 72 + (tid & 7) * 8; bf16_t* const Bsw = Bs + (tid >> 3) * 72 + (tid & 7) * 8;
    bf16x8 ra[4], rb[4];
#pragma unroll
    for (int i = 0; i < 4; ++i) { ra[i] = *(const bf16x8*)(Ab + (size_t)i * 64 * lda); rb[i] = *(const bf16x8*)(Bb + (size_t)i * 64 * ldb); }
#pragma unroll 1
    for (int k0 = 0; k0 < K; k0 += 64) {
      __syncthreads();
#pragma unroll
      for (int i = 0; i < 4; ++i) { *(bf16x8*)(Asw + i * 64 * 72) = ra[i]; *(bf16x8*)(Bsw + i * 64 * 72) = rb[i]; }
      __syncthreads();
      if (k0 + 64 < K) {
        Ab += 64; Bb += 64;
#pragma unroll
        for (int i = 0; i < 4; ++i) { ra[i] = *(const bf16x8*)(Ab + (size_t)i * 64 * lda); rb[i] = *(const bf16x8*)(Bb + (size_t)i * 64 * ldb); }
      }
#pragma unroll
      for (int ks = 0; ks < 2; ++ks) {
        bf16x8 bfr[2][2];
#pragma unroll
        for (int bj = 0; bj < 2; ++bj)
#pragma unroll
          for (int n = 0; n < 2; ++n) bfr[bj][n] = *(const bf16x8*)(Bs + (128 * bj + 32 * wc + 16 * n + fr) * 72 + ks * 32 + fq * 8);
#pragma unroll
        for (int ai = 0; ai < 2; ++ai) {
          bf16x8 af[4];
#pragma unroll
          for (int m = 0; m < 4; ++m) af[m] = *(const bf16x8*)(As + (128 * ai + 64 * wr + 16 * m + fr) * 72 + ks * 32 + fq * 8);
#pragma unroll
          for (int bj = 0; bj < 2; ++bj)
#pragma unroll
            for (int m = 0; m < 4; ++m)
#pragma unroll
              for (int n = 0; n < 2; ++n) acc[ai][bj][m][n] = MFMA16(bfr[bj][n], af[m], acc[ai][bj][m][n]);
        }
      }
    }
    epi(acc, pm, pn, wr, wc, fr, fq);
  }
  __syncthreads();
}
template <class F>
DI void epi_each(const f32x4 (&acc)[2][2][4][2], int pm, int pn, int wr, int wc, int fr, int fq, const F& f) {
#pragma unroll
  for (int ai = 0; ai < 2; ++ai)
#pragma unroll
    for (int m = 0; m < 4; ++m) {
      const int row = pm * 256 + 128 * ai + 64 * wr + 16 * m + fr;
#pragma unroll
      for (int bj = 0; bj < 2; ++bj)
#pragma unroll
        for (int n = 0; n < 2; ++n) f(row, pn * 256 + 128 * bj + 32 * wc + 16 * n + 4 * fq, acc[ai][bj][m][n]);
    }
}

namespace pg8 {
#define PG8_LAS __attribute__((address_space(3)))
constexpr int BM = 256, BK = 64, HALF = 128, HTB = HALF * BK * 2  , STAGE_BYTES = 8 * HTB, NXCD = 8, WGM = 8;

__host__ __device__ __forceinline__ int lds_byte(int r, int c) { const int st = (r >> 4) * 2 + (c >> 5), rr = r & 15, cc = c & 31, ob = rr * 64 + cc * 2; return st * 1024 + (ob ^ (((ob >> 9) & 1) << 5)); }
__host__ __device__ __forceinline__ void stage_rc(int b, int& R, int& C) { const int st = b / 1024, sb = b % 1024, swz = sb ^ (((sb >> 9) & 1) << 5); R = (st >> 1) * 16 + swz / 64; C = (st & 1) * 32 + (swz % 64) / 2; }
__host__ __device__ __forceinline__ int perm32(int rho) { const int n = rho >> 4, i = rho & 15; return 8 * (i >> 2) + 4 * n + (i & 3); }

struct Unit { int pm, pn; };
struct Gemm { const bf16_t* A; const bf16_t* Bt; int lda, ldb, K; };
struct RowOrder {
    int nN, n, G, c;
    __device__ bool next(int i, Unit& u) const {
        const int x = c & 7, j = c >> 3, per = G >> 3;
        const int s0 = (int)(((long)n * x) >> 3), s1 = (int)(((long)n * (x + 1)) >> 3);
        const int L = s0 + i * per + j;
        if (L >= s1) return false;
        u.pm = L / nN; u.pn = L - u.pm * nN; return true;
    }
    __device__ __forceinline__ void a_ready(const Unit&) const {}
    __device__ __forceinline__ void done(const Unit&) const {}
};
template <class Epi, class Sched, bool STAMP = false>
__device__ __forceinline__ void gemm_phase(PG8_LAS unsigned char* lds, const Gemm g, const Sched& S, const Epi& E, unsigned long long* stamps) {
    const int tid = otid(), wid = __builtin_amdgcn_readfirstlane(tid >> 6), lane = tid & 63, wr = wid >> 2, wc = wid & 3, fr = lane & 15, fq = lane >> 4;
    const int K = g.K, nt = K / BK;
    int ts_lo = 0, ts_hi = 0, nts = 0; const unsigned long long rt_entry = STAMP ? (unsigned long long)wall_clock64() : 0ull;
#define PG8_STAMP() do { if (STAMP && wid == 0 && nts < 64) { const unsigned long long _c = (unsigned long long)clock64(); \
        ts_lo = (lane == nts) ? (int)(unsigned)_c : ts_lo; ts_hi = (lane == nts) ? (int)(unsigned)(_c >> 32) : ts_hi; ++nts; } } while (0)
    PG8_STAMP();
    unsigned voffA[2], voffB[2];
#pragma unroll
    for (int i = 0; i < 2; ++i) { int R, C; stage_rc(tid * 16 + i * 8192, R, C); const int Rb = Epi::PERM ? ((R & ~31) + perm32(R & 31)) : R;
        voffA[i] = (unsigned)(R * g.lda + C) * 2u; voffB[i] = (unsigned)(Rb * g.ldb + C) * 2u; }
    const size_t kstep = (size_t)(BK * 2);
    const size_t hstepA = (size_t)HALF * g.lda * 2, hstepB = (size_t)HALF * g.ldb * 2;
    const size_t tstepA = 2 * hstepA, tstepB = 2 * hstepB;
    const unsigned ldsw = (unsigned)wid * 1024u;
    const int aoff = lds_byte(wr * 64 + fr, fq * 8), boff = lds_byte(wc * 32 + fr, fq * 8);
#define PG8_SA(b, h) (((b) * 2 + (h)) * HTB)
#define PG8_SB(b, h) ((4 + (b) * 2 + (h)) * HTB)
#define PG8_STAGE(bufoff, gbase, voff) do { _Pragma("unroll") for (int _i = 0; _i < 2; ++_i) \
        __builtin_amdgcn_global_load_lds((const unsigned*)((const char*)(gbase) + (voff)[_i]), (PG8_LAS unsigned*)(lds + (bufoff) + ldsw + _i * 8192), 16, 0, 0); } while (0)
#define PG8_LDA(dst, b, h) do { _Pragma("unroll") for (int m = 0; m < 4; ++m) _Pragma("unroll") for (int k = 0; k < 2; ++k) dst[m][k] = *(const PG8_LAS bf16x8*)(lds + PG8_SA(b, h) + aoff + m * 2048 + k * 1024); } while (0)
#define PG8_LDB(dst, b, h) do { _Pragma("unroll") for (int n = 0; n < 2; ++n) _Pragma("unroll") for (int k = 0; k < 2; ++k) dst[n][k] = *(const PG8_LAS bf16x8*)(lds + PG8_SB(b, h) + boff + n * 2048 + k * 1024); } while (0)
#define PG8_MMA(ai, bj, At, Bt) do { __builtin_amdgcn_s_setprio(1); _Pragma("unroll") for (int m = 0; m < 4; ++m) _Pragma("unroll") for (int n = 0; n < 2; ++n) _Pragma("unroll") for (int k = 0; k < 2; ++k) \
        acc[ai][bj][m][n] = __builtin_amdgcn_mfma_f32_16x16x32_bf16(Bt[n][k], At[m][k], acc[ai][bj][m][n], 0, 0, 0); __builtin_amdgcn_s_setprio(0); } while (0)
#define PG8_WAIT_V(n) asm volatile("s_waitcnt vmcnt(" #n ")" ::: "memory")
#define PG8_WAIT_L(n) asm volatile("s_waitcnt lgkmcnt(" #n ")" ::: "memory")
#define PG8_BAR __builtin_amdgcn_s_barrier()
#define PG8_SCHED __builtin_amdgcn_sched_barrier(0)
    Unit cur, nxt; int ui = 0;
    if (!S.next(0, cur)) return;
    f32x4 acc[2][2][4][2];
#pragma unroll
    for (int a = 0; a < 2; ++a)
#pragma unroll
        for (int b = 0; b < 2; ++b)
#pragma unroll
            for (int m = 0; m < 4; ++m)
#pragma unroll
                for (int n = 0; n < 2; ++n) acc[a][b][m][n] = (f32x4){0.f, 0.f, 0.f, 0.f};
    bf16x8 At[4][2], B0[2][2], B1[2][2];
    const char* cA = (const char*)g.A + (size_t)cur.pm * tstepA; const char* cB = (const char*)g.Bt + (size_t)cur.pn * tstepB;
    S.a_ready(cur);
    PG8_STAGE(PG8_SB(0, 0), cB, voffB); PG8_STAGE(PG8_SA(0, 0), cA, voffA); PG8_STAGE(PG8_SB(0, 1), cB + hstepB, voffB); PG8_STAGE(PG8_SA(0, 1), cA + hstepA, voffA);
    if (wr == 1) PG8_BAR;
    PG8_WAIT_V(4); PG8_BAR;
    PG8_STAGE(PG8_SB(1, 0), cB + kstep, voffB); PG8_STAGE(PG8_SA(1, 0), cA + kstep, voffA); PG8_STAGE(PG8_SB(1, 1), cB + hstepB + kstep, voffB);
    PG8_WAIT_V(6); PG8_BAR;
    PG8_STAMP();
    for (;;) {
        const bool has_next = S.next(ui + 1, nxt);
        const char* nA = has_next ? (const char*)g.A + (size_t)nxt.pm * tstepA : cA; const char* nB = has_next ? (const char*)g.Bt + (size_t)nxt.pn * tstepB : cB;
        for (int t = 0; t < nt; t += 2) {
            const bool last = (t == nt - 2);
            const char* a1 = cA + (size_t)(t + 1) * kstep;
            const char* a2 = last ? nA : cA + (size_t)(t + 2) * kstep; const char* b2 = last ? nB : cB + (size_t)(t + 2) * kstep;
            const char* a3 = a2 + kstep; const char* b3 = b2 + kstep;
            if (last && has_next) S.a_ready(nxt);
            PG8_LDB(B0, 0, 0); PG8_SCHED; PG8_LDA(At, 0, 0); PG8_STAGE(PG8_SA(1, 1), a1 + hstepA, voffA);
            PG8_WAIT_L(8); PG8_BAR; PG8_WAIT_L(0); PG8_MMA(0, 0, At, B0); PG8_BAR; PG8_SCHED;
            PG8_LDB(B1, 0, 1); PG8_STAGE(PG8_SB(0, 0), b2, voffB);
            PG8_BAR; PG8_WAIT_L(0); PG8_MMA(0, 1, At, B1); PG8_BAR;
            PG8_LDA(At, 0, 1); PG8_STAGE(PG8_SA(0, 0), a2, voffA);
            PG8_BAR; PG8_WAIT_L(0); PG8_MMA(1, 0, At, B0); PG8_BAR; PG8_SCHED;
            PG8_STAGE(PG8_SB(0, 1), b2 + hstepB, voffB);
            PG8_WAIT_V(6); PG8_BAR; PG8_MMA(1, 1, At, B1); PG8_BAR;
            PG8_LDB(B0, 1, 0); PG8_SCHED; PG8_LDA(At, 1, 0); PG8_STAGE(PG8_SA(0, 1), a2 + hstepA, voffA);
            PG8_WAIT_L(8); PG8_BAR; PG8_WAIT_L(0); PG8_MMA(0, 0, At, B0); PG8_BAR; PG8_SCHED;
            PG8_LDB(B1, 1, 1); PG8_STAGE(PG8_SB(1, 0), b3, voffB);
            PG8_BAR; PG8_WAIT_L(0); PG8_MMA(0, 1, At, B1); PG8_BAR;
            PG8_LDA(At, 1, 1); PG8_STAGE(PG8_SA(1, 0), a3, voffA);
            PG8_BAR; PG8_WAIT_L(0); PG8_MMA(1, 0, At, B0); PG8_BAR; PG8_SCHED;
            PG8_STAGE(PG8_SB(1, 1), b3 + hstepB, voffB);
            PG8_WAIT_V(6); PG8_BAR; PG8_MMA(1, 1, At, B1); PG8_BAR;
        }
        PG8_STAMP();
        if constexpr (!Epi::AFTER_DRAIN) { E(acc, cur, wr, wc, fr, fq); S.done(cur); }
        PG8_STAMP();
        if (!has_next) break;
#pragma unroll
        for (int a = 0; a < 2; ++a)
#pragma unroll
            for (int b = 0; b < 2; ++b)
#pragma unroll
                for (int m = 0; m < 4; ++m)
#pragma unroll
                    for (int n = 0; n < 2; ++n) acc[a][b][m][n] = (f32x4){0.f, 0.f, 0.f, 0.f};
        cur = nxt; cA = nA; cB = nB; ++ui;
    }
    PG8_WAIT_V(0);
    if (wr == 0) PG8_BAR;
    PG8_BAR;
    if constexpr (Epi::AFTER_DRAIN) { E.fused(acc, cur, wr, wc, fr, fq, lds, wid, lane); S.done(cur); }
    PG8_STAMP();
    if (STAMP && wid == 0) { stamps[lane] = lane < nts ? (((unsigned long long)(unsigned)ts_hi << 32) | (unsigned)ts_lo) : 0ull;
        if (lane == 62) stamps[62] = rt_entry; if (lane == 63) stamps[63] = (unsigned long long)wall_clock64(); }
#undef PG8_STAMP
#undef PG8_SA
#undef PG8_SB
#undef PG8_STAGE
#undef PG8_LDA
#undef PG8_LDB
#undef PG8_MMA
#undef PG8_WAIT_V
#undef PG8_WAIT_L
#undef PG8_BAR
#undef PG8_SCHED
}
}

template <class Epi>
struct EpiAdapt { static constexpr bool PERM = false, AFTER_DRAIN = false; const Epi& e;
  __device__ __forceinline__ void operator()(const f32x4 (&acc)[2][2][4][2], const pg8::Unit& u, int wr, int wc, int fr, int fq) const { e(acc, u.pm, u.pn, wr, wc, fr, fq); } };
template <class Epi>
struct EpiAdaptP { static constexpr bool PERM = true, AFTER_DRAIN = false; const Epi& e;
  __device__ __forceinline__ void operator()(const f32x4 (&acc)[2][2][4][2], const pg8::Unit& u, int wr, int wc, int fr, int fq) const { e(acc, u.pm, u.pn, wr, wc, fr, fq); } };
template <class Epi>
DI void gemm_fast_p(char* lds, const bf16_t* A, int lda, const bf16_t* Bt, int ldb, int nM, int nN, int K, const Epi& epi) {
  asm volatile("" : "+s"(K), "+s"(lda), "+s"(ldb));
  pg8::Gemm g{A, Bt, lda, ldb, K}; pg8::RowOrder S{nN, nM * nN, (int)gridDim.x, (int)blockIdx.x}; EpiAdaptP<Epi> E{epi};
  __syncthreads();
  pg8::gemm_phase<EpiAdaptP<Epi>, pg8::RowOrder, false>((PG8_LAS unsigned char*)lds, g, S, E, nullptr);
  __syncthreads();
}
template <class F>
DI void epi_each8(const f32x4 (&acc)[2][2][4][2], int pm, int pn, int wr, int wc, int fr, int fq, const F& f) {
#pragma unroll
  for (int ai = 0; ai < 2; ++ai)
#pragma unroll
    for (int m = 0; m < 4; ++m) {
      const int row = pm * 256 + 128 * ai + 64 * wr + 16 * m + fr;
#pragma unroll
      for (int bj = 0; bj < 2; ++bj) f(row, pn * 256 + 128 * bj + 32 * wc + 8 * fq, acc[ai][bj][m][0], acc[ai][bj][m][1]);
    }
}
DI void st_bf8v(bf16_t* dst, f32x4 a, f32x4 b) { uint4 w; w.x = cvt_pk(a[0], a[1]); w.y = cvt_pk(a[2], a[3]); w.z = cvt_pk(b[0], b[1]); w.w = cvt_pk(b[2], b[3]); *(uint4*)dst = w; }
template <class Epi>
DI void gemm_fast(char* lds, const bf16_t* A, int lda, const bf16_t* Bt, int ldb, int nM, int nN, int K, const Epi& epi) {
  asm volatile("" : "+s"(K), "+s"(lda), "+s"(ldb));
  pg8::Gemm g{A, Bt, lda, ldb, K}; pg8::RowOrder S{nN, nM * nN, (int)gridDim.x, (int)blockIdx.x}; EpiAdapt<Epi> E{epi};
  __syncthreads();
  pg8::gemm_phase<EpiAdapt<Epi>, pg8::RowOrder, false>((PG8_LAS unsigned char*)lds, g, S, E, nullptr);
  __syncthreads();
}
DI void phase_p2x(PmK p, int l) {
  LAUNDER(p);
  const int tid_ = otid(), wid = tid_ >> 6, lane = tid_ & 63;
  bf16_t* dqkv = (bf16_t*)(p->ws + OFF_DQKV);
  const int hd = lane >> 2, part = lane & 3;
  const float* g = (hd < 8 ? p->dq_g : p->dk_g) + l * 64 + part * 16;
  float gv[16];
#pragma unroll
  for (int e = 0; e < 16; ++e) gv[e] = g[e];
  const float qs = hd < 8 ? 0.125f * LOG2E : 1.f;
  for (int r = blockIdx.x * 8 + wid; r < R; r += gridDim.x * 8) {
    const int b = r / TP, pp = r - b * TP;
    bf16_t* ptr = dqkv + (size_t)r * 1536 + lane * 16;
    float v[16]; ld_bf8(ptr, v); ld_bf8(ptr + 8, v + 8);
    float ss = 0.f;
#pragma unroll
    for (int e = 0; e < 16; ++e) ss += v[e] * v[e];
    ss += __shfl_xor(ss, 1); ss += __shfl_xor(ss, 2);
    const float rinv = rsqrtf(ss * (1.f / 64.f) + 1e-6f) * qs;
#pragma unroll
    for (int e = 0; e < 16; ++e) v[e] *= rinv * gv[e];
    if (part == 0) {
      const float t = (float)(pp - PAD0);
#pragma unroll
      for (int i = 0; i < 8; ++i) {
        float c, s; sincos_rev(t * p->inv_d[i], c, s);
        const float x1 = v[i], x2 = v[i + 8];
        v[i] = x1 * c - x2 * s; v[i + 8] = x2 * c + x1 * s;
      }
    }
    st_bf8(ptr, v); st_bf8(ptr + 8, v + 8);
  }
}

DI void phase_p3(PmK p, int l, char* lds) {
  LAUNDER(p);
  const int tid_ = otid(), wid = tid_ >> 6, lane = tid_ & 63;
  float* wl = (float*)lds + wid * 2048;
  float* sq = wl; float* sa = wl + 768; float* sk = wl + 1440; float* scs = wl + 1952; float* ssn = wl + 1968;
  bf16_t* mq = (bf16_t*)(p->ws + OFF_MQ); bf16_t* mk = (bf16_t*)(p->ws + OFF_MK);
  const bf16_t* pa = (const bf16_t*)(p->ws + OFF_PA); const bf16_t* knr = (const bf16_t*)(p->ws + OFF_KNR);
  const float* qg = p->q_head_g + l * 96; const float* kg = p->k_head_g + l * 96;
  const float qscale = 0.10206207261596577f * LOG2E;
  const int h = lane >> 3, e0 = (lane & 7) * 12;
  float gq[12], gk[12], gqp[12], gkp[12];
#pragma unroll
  for (int e = 0; e < 12; ++e) { const int d = e0 + e, pd = d < 16 ? d + 16 : (d < 32 ? d - 16 : d); gq[e] = qg[d]; gk[e] = kg[d]; gqp[e] = qg[pd]; gkp[e] = kg[pd]; }
  for (int r = blockIdx.x * 8 + wid; r < R; r += gridDim.x * 8) {
    const int b = r / TP, pp = r - b * TP;
    for (int i = lane; i < 192; i += 64) { const f32x4 v = ld_bf4(mq + (size_t)r * 768 + i * 4); *(f32x4*)(sq + i * 4) = v; }
    for (int i = lane; i < 168; i += 64) { const f32x4 v = ld_bf4(pa + (size_t)r * 672 + i * 4); *(f32x4*)(sa + i * 4) = v; }
    for (int i = lane; i < 128; i += 64) { const f32x4 v = ld_bf4(knr + (size_t)r * 512 + i * 4); *(f32x4*)(sk + i * 4) = v; }
    if (lane < 16) { float c, s; sincos_rev((float)(pp - PAD0) * p->inv_m[lane], c, s); scs[lane] = c; ssn[lane] = s; }
    __syncthreads();
    float s1 = 0.f, s2 = 0.f;
    for (int i = lane; i < 384; i += 64) s1 += sa[i] * sa[i];
    for (int i = lane; i < 256; i += 64) s2 += sa[384 + i] * sa[384 + i];
    s1 = wsum(s1); s2 = wsum(s2);
    const float rq = rsqrtf(s1 * (1.f / 384.f) + 1e-6f), rkv = rsqrtf(s2 * (1.f / 256.f) + 1e-6f);
    float ssq = 0.f, ssk = 0.f;
#pragma unroll
    for (int e = 0; e < 12; ++e) {
      const int d = e0 + e; const float qv = sq[h * 96 + d] * rq; ssq += qv * qv;
      const float kv = d < 32 ? sa[640 + d] : sk[h * 64 + d - 32] * rkv; ssk += kv * kv;
    }
    ssq += __shfl_xor(ssq, 1); ssq += __shfl_xor(ssq, 2); ssq += __shfl_xor(ssq, 4);
    ssk += __shfl_xor(ssk, 1); ssk += __shfl_xor(ssk, 2); ssk += __shfl_xor(ssk, 4);
    const float nq = rsqrtf(ssq * (1.f / 96.f) + 1e-6f) * rq * qscale, nk = rsqrtf(ssk * (1.f / 96.f) + 1e-6f);
    float oq[12], ok[12];
#pragma unroll
    for (int e = 0; e < 12; ++e) {
      const int d = e0 + e;
      const int pd = d < 16 ? d + 16 : d - 16;
      const float kraw = d < 32 ? sa[640 + d] : sk[h * 64 + d - 32] * rkv;
      const float qo = sq[h * 96 + d] * nq * gq[e], ko = kraw * nk * gk[e];
      if (d < 32) {
        const float qp = sq[h * 96 + pd] * nq * gqp[e], kp = sa[640 + pd] * nk * gkp[e];
        const float c = scs[d & 15], sn = ssn[d & 15];
        oq[e] = d < 16 ? qo * c - qp * sn : qo * c + qp * sn; ok[e] = d < 16 ? ko * c - kp * sn : ko * c + kp * sn;
      } else { oq[e] = qo; ok[e] = ko; }
    }
    __syncthreads();
    bf16_t* dq = mq + (size_t)r * 768 + lane * 12; bf16_t* dk = mk + (size_t)r * 768 + lane * 12;
#pragma unroll
    for (int e = 0; e < 12; e += 4) { st_bf4(dq + e, (f32x4){oq[e], oq[e + 1], oq[e + 2], oq[e + 3]}); st_bf4(dk + e, (f32x4){ok[e], ok[e + 1], ok[e + 2], ok[e + 3]}); }
    __syncthreads();
  }
}

DI void phase_p2y(PmK p, int l) {
  LAUNDER(p);
  const int tid_ = otid(), wid = tid_ >> 6, lane = tid_ & 63;
  const bf16_t* xr = (const bf16_t*)(p->ws + OFF_XBCR); bf16_t* xc = (bf16_t*)(p->ws + OFF_XBCC); float* gates = (float*)(p->ws + OFF_GATES);
  const float* cw = p->conv_w + (size_t)l * 5 * 768; const float* cb = p->conv_b + l * 768;
  const int c0 = lane * 12;
  float wreg[5][12], breg[12];
#pragma unroll
  for (int e = 0; e < 12; ++e) { breg[e] = cb[c0 + e];
#pragma unroll
    for (int j = 0; j < 5; ++j) wreg[j][e] = cw[j * 768 + c0 + e]; }
  for (int r = blockIdx.x * 8 + wid; r < R; r += gridDim.x * 8) {
    const int b = r / TP, pp = r - b * TP;
    bf16_t* dst = xc + (size_t)r * 768 + c0;
    if (pp < PAD0) {
      unsigned zz = 0u; asm volatile("" : "+v"(zz)); const uint2 z = {zz, zz};
      *(uint2*)dst = z; *(uint2*)(dst + 4) = z; *(uint2*)(dst + 8) = z;
      if (lane < 32) gates[(size_t)r * 32 + lane] = lane < 16 ? 0.f : (lane < 24 ? NEGF : 0.f);
      continue;
    }
    float acc[12];
#pragma unroll
    for (int e = 0; e < 12; ++e) acc[e] = breg[e];
#pragma unroll
    for (int j = 0; j < 5; ++j) {
      const int q = pp + j - 2;
      if (q >= PAD0 && q < TP) {
        const bf16_t* src = xr + (size_t)(r + j - 2) * 768 + c0;
#pragma unroll
        for (int e = 0; e < 12; e += 4) { const f32x4 v = ld_bf4(src + e);
          acc[e] += wreg[j][e] * v[0]; acc[e + 1] += wreg[j][e + 1] * v[1]; acc[e + 2] += wreg[j][e + 2] * v[2]; acc[e + 3] += wreg[j][e + 3] * v[3]; }
      }
    }
#pragma unroll
    for (int e = 0; e < 12; e += 4) st_bf4(dst + e, (f32x4){siluf(acc[e]), siluf(acc[e + 1]), siluf(acc[e + 2]), siluf(acc[e + 3])});
    if (lane < 32) {
      float v = gates[(size_t)r * 32 + lane];
      if (lane < 16) v = softplusf(v + p->dt_bias[l * 16 + lane]);
      else if (lane < 24) v = v + p->i_bias[l * 8 + lane - 16];
      else v = -softplusf(-(v + p->f_bias[l * 8 + lane - 24]));
      gates[(size_t)r * 32 + lane] = v;
    }
  }
}

DI void unpk8(const uint4 w, float* v) { v[0] = bflo(w.x); v[1] = bfhi(w.x); v[2] = bflo(w.y); v[3] = bfhi(w.y); v[4] = bflo(w.z); v[5] = bfhi(w.z); v[6] = bflo(w.w); v[7] = bfhi(w.w); }
DI void phase_post(PmK p, int l) {
  LAUNDER(p);
  const int tid_ = otid(), wid = tid_ >> 6, lane = tid_ & 63;
  bf16_t* mixed = (bf16_t*)(p->ws + OFF_MIXED); const bf16_t* sz = (const bf16_t*)(p->ws + OFF_SZ); const bf16_t* mo = (const bf16_t*)(p->ws + OFF_MQKVO);
  const float one_m_l = 1.f - p->linit[l];
  float g0[8], g1[8], g2[8], g3[8];
#pragma unroll
  for (int e = 0; e < 8; ++e) { g0[e] = p->mla_out_g[l * 512 + lane * 8 + e]; g1[e] = p->ssd_norm_g[l * 512 + lane * 8 + e];
    g2[e] = p->dout_g[l * 128 + (lane & 15) * 8 + e] * one_m_l; g3[e] = p->ml_out_g[l * 128 + (lane & 15) * 8 + e]; }
  for (int r = blockIdx.x * 8 + wid; r < R; r += gridDim.x * 8) {
    const int b = r / TP, pp = r - b * TP;
    if (pp < PAD0) continue;
    bf16_t* row = mixed + (size_t)r * 2048 + lane * 8;
    const uint4 w0 = *(const uint4*)row, w1 = *(const uint4*)(row + 512), w2 = *(const uint4*)(row + 1024), w3 = *(const uint4*)(row + 1536);
    const uint4 wz = *(const uint4*)(sz + (size_t)r * 512 + lane * 8), wo = *(const uint4*)(mo + (size_t)r * 1536 + 1024 + lane * 8);
    float v0[8], v1[8], v2[8], v3[8], z[8], og[8];
    unpk8(w0, v0); unpk8(w1, v1); unpk8(w2, v2); unpk8(w3, v3); unpk8(wz, z); unpk8(wo, og);
    float s0 = 0.f, s1 = 0.f, s2 = 0.f, s3 = 0.f;
#pragma unroll
    for (int e = 0; e < 8; ++e) { v1[e] *= siluf(z[e]); s0 += v0[e] * v0[e]; s1 += v1[e] * v1[e]; s2 += v2[e] * v2[e]; s3 += v3[e] * v3[e]; }
#pragma unroll
    for (int m = 1; m <= 8; m <<= 1) { s0 += __shfl_xor(s0, m); s1 += __shfl_xor(s1, m); s2 += __shfl_xor(s2, m); s3 += __shfl_xor(s3, m); }
    s0 += __shfl_xor(s0, 16); s1 += __shfl_xor(s1, 16); s0 += __shfl_xor(s0, 32); s1 += __shfl_xor(s1, 32);
    const float r0 = rsqrtf(s0 * (1.f / 512.f) + 1e-6f), r1 = rsqrtf(s1 * (1.f / 512.f) + 1e-6f), r2 = rsqrtf(s2 * (1.f / 128.f) + 1e-6f), r3 = rsqrtf(s3 * (1.f / 128.f) + 1e-6f);
#pragma unroll
    for (int e = 0; e < 8; ++e) { v0[e] *= r0 * g0[e]; v1[e] *= r1 * g1[e]; v2[e] *= r2 * g2[e]; v3[e] *= r3 * g3[e] * sigmf(og[e]); }
    st_bf8(row, v0); st_bf8(row + 512, v1); st_bf8(row + 1024, v2); st_bf8(row + 1536, v3);
  }
}

DI void vtrans_items(PmK p, char* lds) {
  LAUNDER(p);
  const int tid = otid();
  bf16_t* T = (bf16_t*)lds;
  float* s_r = (float*)(T + 64 * 520);
  const bf16_t* pa = (const bf16_t*)(p->ws + OFF_PA); const bf16_t* mvr = (const bf16_t*)(p->ws + OFF_MVR); const bf16_t* dqkv = (const bf16_t*)(p->ws + OFF_DQKV);
  bf16_t* mvt = (bf16_t*)(p->ws + OFF_MVT); bf16_t* dvt = (bf16_t*)(p->ws + OFF_DVT);
  for (int it = blockIdx.x; it < 2 * NB * 130; it += gridDim.x) {
    const int which = it / (NB * 130), rem = it - which * (NB * 130), b = rem / 130, pc = rem - b * 130, r0 = b * TP + pc * 64;
    __syncthreads();
    if (which == 0) {
      const int row = tid >> 3, sub = tid & 7; float ss = 0.f;
#pragma unroll
      for (int e = 0; e < 4; ++e) { float v[8]; ld_bf8(pa + (size_t)(r0 + row) * 672 + 384 + sub * 32 + e * 8, v);
#pragma unroll
        for (int q = 0; q < 8; ++q) ss += v[q] * v[q]; }
      ss += __shfl_xor(ss, 1); ss += __shfl_xor(ss, 2); ss += __shfl_xor(ss, 4);
      if (sub == 0) s_r[row] = rsqrtf(ss * (1.f / 256.f) + 1e-6f);
    }
    __syncthreads();
    const bf16_t* src = which ? dqkv + 1024 : mvr; const int ld = which ? 1536 : 512;
#pragma unroll
    for (int i = 0; i < 8; ++i) {
      const int id = tid + 512 * i, row = id >> 6, cc = id & 63;
      if (which) *(uint4*)(T + row * 520 + cc * 8) = *(const uint4*)(src + (size_t)(r0 + row) * ld + cc * 8);
      else { float v[8]; ld_bf8(src + (size_t)(r0 + row) * ld + cc * 8, v); const float sc = s_r[row];
#pragma unroll
        for (int q = 0; q < 8; ++q) v[q] *= sc;
        st_bf8(T + row * 520 + cc * 8, v); }
    }
    __syncthreads();
    bf16_t* dT = (which ? dvt : mvt) + (size_t)b * 512 * TP + pc * 64;
#pragma unroll
    for (int i = 0; i < 8; ++i) {
      const int id = tid + 512 * i, c = id >> 3, pch = id & 7;
      bf16x8 o;
#pragma unroll
      for (int e = 0; e < 8; ++e) { const int pd = pch * 8 + e, ps = (pd & ~12) | ((pd & 4) << 1) | ((pd & 8) >> 1);
        o[e] = (short)T[ps * 520 + c]; }
      *(bf16x8*)(dT + (size_t)c * TP + pch * 8) = o;
    }
  }
  __syncthreads();
}

typedef float f32x16 __attribute__((ext_vector_type(16)));
#define MFMA32(a, b, c) __builtin_amdgcn_mfma_f32_32x32x16_bf16((a), (b), (c), 0, 0, 0)
DI int crow(int i, int hi) { return (i & 3) + 8 * (i >> 2) + 4 * hi; }

template <int DQK, int DV, bool SECOND>
DI void attn32(char* lds, const bf16_t* __restrict__ Qb, int ldq, const bf16_t* __restrict__ Kb, int ldk, const bf16_t* __restrict__ VTb, int q0,
               bf16_t* dstb, float lam) {
  constexpr int KS = DQK + 8, VS = 72, NKS = DQK / 16, NDB = DV / 32, KCH = DQK / 8;
  constexpr int NK = 64 * KCH, NV = DV * 8, NCHK = NK + NV, CI = (NCHK + 511) / 512, NT = TP / 64, KBUF = 64 * KS, VBUF = DV * VS;
  bf16_t* LK = (bf16_t*)lds; bf16_t* LV = LK + 2 * KBUF;
  const int tid = otid(), wid = tid >> 6, lane = tid & 63, r32 = lane & 31, hi = lane >> 5;
  const int prow = q0 + 32 * wid + r32, pc = prow < 0 ? 0 : prow;
  const bool active = __builtin_amdgcn_readfirstlane(q0 + 32 * wid + 31) >= PAD0;
  bf16x8 qf[NKS];
#pragma unroll
  for (int ks = 0; ks < NKS; ++ks) qf[ks] = *(const bf16x8*)(Qb + (size_t)pc * ldq + 16 * ks + 8 * hi);
  f32x16 o[NDB];
#pragma unroll
  for (int db = 0; db < NDB; ++db)
#pragma unroll
    for (int i = 0; i < 16; ++i) o[db][i] = 0.f;
  float m = NEGF, lsum = 0.f;
  bf16x8 st[CI];
#define A32_GLOAD(ktk, ktv) do { int tl_ = tid; asm volatile("" : "+v"(tl_)); _Pragma("unroll") for (int i = 0; i < CI; ++i) { const int id0 = tl_ + 512 * i, id = id0 < NCHK ? id0 : NCHK - 1; { \
      if (id < NK) { const int row = id / KCH, cc = id - row * KCH; st[i] = *(const bf16x8*)(Kb + (size_t)((ktk) * 64 + row) * ldk + cc * 8); } \
      else { const int v = id - NK, d = v >> 3, cc = v & 7; st[i] = *(const bf16x8*)(VTb + (size_t)d * TP + (ktv) * 64 + cc * 8); } } } } while (0)
#define A32_LSTORE(kbuf, vbuf, dok, dov) do { int tl_ = tid; asm volatile("" : "+v"(tl_)); _Pragma("unroll") for (int i = 0; i < CI; ++i) { const int id = tl_ + 512 * i; if (id < NCHK) { \
      if (id < NK) { if (dok) { const int row = id / KCH, cc = id - row * KCH; *(bf16x8*)(LK + (kbuf) * KBUF + row * KS + cc * 8) = st[i]; } } \
      else { if (dov) { const int v = id - NK, d = v >> 3, cc = v & 7; *(bf16x8*)(LV + (vbuf) * VBUF + d * VS + cc * 8) = st[i]; } } } } } while (0)
#define A32_QK(S0, S1, kt) do { const bf16_t* Ks = LK + ((kt) & 1) * KBUF; \
    _Pragma("unroll") for (int i = 0; i < 16; ++i) { S0[i] = 0.f; S1[i] = 0.f; } \
    _Pragma("unroll") for (int ks = 0; ks < NKS; ++ks) { \
      const bf16x8 ka0 = *(const bf16x8*)(Ks + r32 * KS + 16 * ks + 8 * hi), ka1 = *(const bf16x8*)(Ks + (32 + r32) * KS + 16 * ks + 8 * hi); \
      S0 = MFMA32(ka0, qf[ks], S0); S1 = MFMA32(ka1, qf[ks], S1); } } while (0)
#define A32_SOFT_PV(S0, S1, kt) do { \
    float mxa = fmaxf(S0[0], S0[1]), mxb = fmaxf(S1[0], S1[1]); \
    _Pragma("unroll") for (int i = 2; i < 16; i += 2) { mxa = fmaxf(mxa, fmaxf(S0[i], S0[i + 1])); mxb = fmaxf(mxb, fmaxf(S1[i], S1[i + 1])); } \
    float mx = fmaxf(mxa, mxb); mx = fmaxf(mx, __shfl_xor(mx, 32)); \
    const float mn = fmaxf(m, mx), alpha = __builtin_amdgcn_exp2f(m - mn); m = mn; \
    const f32x2 mn2 = {mn, mn}, al2 = {alpha, alpha}; f32x2 rsa = {0.f, 0.f}, rsb = {0.f, 0.f}; \
    _Pragma("unroll") for (int i = 0; i < 16; i += 2) { \
      f32x2 t = (f32x2){S0[i], S0[i + 1]} - mn2; t[0] = __builtin_amdgcn_exp2f(t[0]); t[1] = __builtin_amdgcn_exp2f(t[1]); rsa += t; S0[i] = t[0]; S0[i + 1] = t[1]; \
      f32x2 u = (f32x2){S1[i], S1[i + 1]} - mn2; u[0] = __builtin_amdgcn_exp2f(u[0]); u[1] = __builtin_amdgcn_exp2f(u[1]); rsb += u; S1[i] = u[0]; S1[i + 1] = u[1]; } \
    lsum = lsum * alpha + ((rsa[0] + rsa[1]) + (rsb[0] + rsb[1])); \
    _Pragma("unroll") for (int db = 0; db < NDB; ++db) _Pragma("unroll") for (int i = 0; i < 16; i += 2) { const f32x2 t = (f32x2){o[db][i], o[db][i + 1]} * al2; o[db][i] = t[0]; o[db][i + 1] = t[1]; } \
    const bf16_t* Vt = LV + ((kt) & 1) * VBUF; \
    _Pragma("unroll") for (int s4 = 0; s4 < 4; ++s4) { const int b8 = 8 * (s4 & 1); u32x4 w; \
      if (s4 < 2) w = (u32x4){cvt_pk(S0[b8], S0[b8 + 1]), cvt_pk(S0[b8 + 2], S0[b8 + 3]), cvt_pk(S0[b8 + 4], S0[b8 + 5]), cvt_pk(S0[b8 + 6], S0[b8 + 7])}; \
      else w = (u32x4){cvt_pk(S1[b8], S1[b8 + 1]), cvt_pk(S1[b8 + 2], S1[b8 + 3]), cvt_pk(S1[b8 + 4], S1[b8 + 5]), cvt_pk(S1[b8 + 6], S1[b8 + 7])}; \
      const bf16x8 pb = __builtin_bit_cast(bf16x8, w); \
      _Pragma("unroll") for (int db = 0; db < NDB; ++db) { const bf16x8 va = *(const bf16x8*)(Vt + (db * 32 + r32) * VS + 16 * s4 + 8 * hi); o[db] = MFMA32(va, pb, o[db]); } } } while (0)
#define A32_STEP(C0, C1, N0, N1, kt) do { \
    if (active) { if ((kt) + 1 < NT) A32_QK(N0, N1, (kt) + 1); \
    A32_SOFT_PV(C0, C1, kt); } \
    A32_LSTORE(kt & 1, ((kt) + 1) & 1, (kt) + 2 < NT, (kt) + 1 < NT); \
    __syncthreads(); \
    A32_GLOAD(((kt) + 3 < NT ? (kt) + 3 : NT - 1), ((kt) + 2 < NT ? (kt) + 2 : NT - 1)); } while (0)
  f32x16 sa0, sa1, sb0, sb1;
  A32_GLOAD(1, 1); A32_LSTORE(1, 1, true, true); A32_GLOAD(2, 2); __syncthreads();
  A32_QK(sa0, sa1, 1);
#pragma unroll
  for (int i = 0; i < 16; ++i) { if (crow(i, hi) < 48) sa0[i] = NEGF; if (32 + crow(i, hi) < 48) sa1[i] = NEGF; }
  A32_LSTORE(0, 0, true, false); __syncthreads(); A32_GLOAD(3, 2);
#pragma unroll 1
  for (int kt = 1; kt + 1 < NT; kt += 2) {
    A32_STEP(sa0, sa1, sb0, sb1, kt);
    A32_STEP(sb0, sb1, sa0, sa1, kt + 1);
  }
  A32_STEP(sa0, sa1, sb0, sb1, NT - 1);
#undef A32_GLOAD
#undef A32_LSTORE
#undef A32_QK
#undef A32_SOFT_PV
#undef A32_STEP
  lsum += __shfl_xor(lsum, 32);
  const float il = 1.f / lsum;
  if (prow >= PAD0) {
    bf16_t* drow = dstb + (size_t)prow * 2048 + 4 * hi;
#pragma unroll
    for (int db = 0; db < NDB; ++db)
#pragma unroll
      for (int g = 0; g < 4; ++g) {
        f32x4 v = {o[db][4 * g] * il, o[db][4 * g + 1] * il, o[db][4 * g + 2] * il, o[db][4 * g + 3] * il};
        bf16_t* ad = drow + db * 32 + 8 * g;
        if (SECOND) { const f32x4 pv = ld_bf4(ad); v = pv - lam * v; }
        st_bf4(ad, v);
      }
  }
  __syncthreads();
}

DI void phase_attn(PmK p, char* lds, int cslot) {
  LAUNDER(p);
  const int tid = otid();
  bf16_t* mixed = (bf16_t*)(p->ws + OFF_MIXED);
  const bf16_t* dqkv = (const bf16_t*)(p->ws + OFF_DQKV);
  const bf16_t* mq = (const bf16_t*)(p->ws + OFF_MQ); const bf16_t* mk = (const bf16_t*)(p->ws + OFF_MK);
  const bf16_t* mvt = (const bf16_t*)(p->ws + OFF_MVT); const bf16_t* dvt = (const bf16_t*)(p->ws + OFF_DVT);
  const float lam = ((const float*)(p->ws + OFF_SCAL))[0];
  int* counter = (int*)(p->ws + OFF_SCAL) + 16 + cslot;
  int* s_it = (int*)(lds + 120 * 1024);
  constexpr int NQ = 33, ND = NB * 4 * NQ, NM = NB * 8 * NQ;
  for (;;) {
    __syncthreads();
    if (tid == 0) *s_it = atomicAdd(counter, 1);
    __syncthreads();
    const int it = *s_it;
    if (it >= ND + NM) break;
    bool isd; int qi, bh;
    if (it < 48) { isd = it < 16; bh = isd ? it : it - 16; qi = 0; }
    else if (it < 48 + 16 * 32) { const int t = it - 48; isd = true; bh = t >> 5; qi = (t & 31) + 1; }
    else { const int t = it - 48 - 16 * 32; isd = false; bh = t >> 5; qi = (t & 31) + 1; }
    const int q0 = 256 * qi - 128;
    if (isd) {
      const int h = bh & 3, b = bh >> 2;
      const bf16_t* base = dqkv + (size_t)b * TP * 1536;
      const bf16_t* vt = dvt + ((size_t)b * 512 + h * 128) * TP;
      bf16_t* dst = mixed + (size_t)b * TP * 2048 + 1024 + h * 128;
      attn32<64, 128, false>(lds, base + (2 * h) * 64, 1536, base + 512 + (2 * h) * 64, 1536, vt, q0, dst, lam);
      attn32<64, 128, true>(lds, base + (2 * h + 1) * 64, 1536, base + 512 + (2 * h + 1) * 64, 1536, vt, q0, dst, lam);
    } else {
      const int h = bh & 7, b = bh >> 3;
      attn32<96, 64, false>(lds, mq + (size_t)b * TP * 768 + h * 96, 768, mk + (size_t)b * TP * 768 + h * 96, 768, mvt + ((size_t)b * 512 + h * 64) * TP, q0,
                            mixed + (size_t)b * TP * 2048 + h * 64, lam);
    }
  }
}

DI void phase_states(PmK p, int l, char* lds) {
  LAUNDER(p);
  const int tid = otid(), wid = tid >> 6, lane = tid & 63, fr = lane & 15, fq = lane >> 4;
  const bf16_t* xc = (const bf16_t*)(p->ws + OFF_XBCC); const float* gates = (const float*)(p->ws + OFF_GATES);
  const bf16_t* mqk = (const bf16_t*)(p->ws + OFF_MQKVO);
  float* ssds = (float*)(p->ws + OFF_SSDS); float* ssdd = (float*)(p->ws + OFF_SSDD);
  float* mls = (float*)(p->ws + OFF_MLS); float* mlg = (float*)(p->ws + OFF_MLG);
  bf16_t* T0 = (bf16_t*)lds;
  bf16_t* T1 = T0 + 64 * 136;
  float* s_a = (float*)(T1 + 144 * 136); float* s_b = s_a + 128; float* s_cum = s_b + 128; float* s_sc = s_cum + 128;
  constexpr int NS = NB * NCH * 8 * 2, NMI = NB * NCH * 4 * 2;
  for (int it = blockIdx.x; it < NS + NMI; it += gridDim.x) {
    __syncthreads();
    if (it < NS) {
      const int dir = it & 1, hh = (it >> 1) & 7, bc = it >> 4, c = bc % NCH, b = bc / NCH, g = hh >> 2;
      const int r0 = b * TP + c * 128;
      const float Ah = -expf(p->a_log[l * 16 + dir * 8 + hh]);
      if (tid < 128) { const float dtv = gates[(size_t)(r0 + tid) * 32 + dir * 8 + hh]; s_b[tid] = dtv; s_a[tid] = dtv * Ah; }
      __syncthreads();
      if (wid == 0) scan128_sum(s_a, s_cum, dir, lane);
      __syncthreads();
      const float tot = dir ? s_cum[0] : s_cum[127];
#pragma unroll
      for (int i = 0; i < 2; ++i) {
        const int id = tid + 512 * i, lrow = id >> 3, c8 = id & 7;
        float xv[8]; ld_bf8(xc + (size_t)(r0 + lrow) * 768 + hh * 64 + c8 * 8, xv);
        const uint4 bw = *(const uint4*)(xc + (size_t)(r0 + lrow) * 768 + 512 + g * 64 + c8 * 8);
        const bf16x8 bv = __builtin_bit_cast(bf16x8, bw);
        const float sc = s_b[lrow] * fexp(tot - s_cum[lrow]);
#pragma unroll
        for (int e = 0; e < 8; ++e) { T0[(c8 * 8 + e) * 136 + lrow] = f2bf(xv[e] * sc); T1[(c8 * 8 + e) * 136 + lrow] = (bf16_t)bv[e]; }
      }
      __syncthreads();
      const int cp = dir ? NCH - 1 - c : c;
      const size_t sidx = (size_t)((b * 8 + hh) * 2 + dir) * NCH + cp;
      for (int t = wid; t < 16; t += 8) {
        const int nt = t & 3, pt = t >> 2;
        const f32x4 acc = mma_lds(T1 + nt * 16 * 136, 136, T0 + pt * 16 * 136, 136, 128, (f32x4){0.f, 0.f, 0.f, 0.f}, fr, fq);
        *(f32x4*)(ssds + sidx * 4096 + (pt * 16 + fr) * 64 + nt * 16 + 4 * fq) = acc;
      }
      if (tid == 0) ssdd[sidx] = fexp(tot);
    } else {
      const int i2 = it - NS, dir = i2 & 1, hm = (i2 >> 1) & 3, bc = i2 >> 3, c = bc % NCH, b = bc / NCH;
      const int r0 = b * TP + c * 128;
      if (tid < 128) { s_a[tid] = gates[(size_t)(r0 + tid) * 32 + 24 + dir * 4 + hm]; s_b[tid] = gates[(size_t)(r0 + tid) * 32 + 16 + dir * 4 + hm]; }
      __syncthreads();
      if (wid == 0) scan128_sum(s_a, s_cum, dir, lane);
      __syncthreads();
      const float glast = dir ? s_cum[0] : s_cum[127];
      if (wid == 0) {
        float mx = fmaxf(glast - s_cum[lane] + s_b[lane], glast - s_cum[lane + 64] + s_b[lane + 64]);
        mx = wmax(mx); if (lane == 0) s_sc[0] = mx;
      }
      __syncthreads();
      const float mloc = s_sc[0];
#pragma unroll
      for (int i = 0; i < 2; ++i) {
        const int id = tid + 512 * i, lrow = id >> 3, c8 = id & 7;
        const uint4 kw = *(const uint4*)(mqk + (size_t)(r0 + lrow) * 1536 + 256 + hm * 64 + c8 * 8);
        const bf16x8 kv = __builtin_bit_cast(bf16x8, kw);
#pragma unroll
        for (int e = 0; e < 8; ++e) T0[(c8 * 8 + e) * 136 + lrow] = (bf16_t)kv[e];
      }
#pragma unroll
      for (int i = 0; i < 4; ++i) {
        const int id = tid + 512 * i, lrow = id >> 4, c8 = id & 15;
        float vv[8]; ld_bf8(mqk + (size_t)(r0 + lrow) * 1536 + 512 + hm * 128 + c8 * 8, vv);
        const float w = fexp(glast - s_cum[lrow] + s_b[lrow] - mloc);
#pragma unroll
        for (int e = 0; e < 8; ++e) T1[(c8 * 8 + e) * 136 + lrow] = f2bf(vv[e] * w);
      }
      for (int id = tid; id < 16 * 128; id += 512) {
        const int vr = id >> 7, lrow = id & 127;
        T1[(128 + vr) * 136 + lrow] = vr == 0 ? f2bf(fexp(glast - s_cum[lrow] + s_b[lrow] - mloc)) : (bf16_t)0;
      }
      __syncthreads();
      const int cp = dir ? NCH - 1 - c : c;
      const size_t sidx = (size_t)((b * 4 + hm) * 2 + dir) * NCH + cp;
      for (int t = wid; t < 36; t += 8) {
        const int dt_ = t & 3, vt = t >> 2;
        const f32x4 acc = mma_lds(T0 + dt_ * 16 * 136, 136, T1 + vt * 16 * 136, 136, 128, (f32x4){0.f, 0.f, 0.f, 0.f}, fr, fq);
        *(f32x4*)(mls + sidx * 9216 + (vt * 16 + fr) * 64 + dt_ * 16 + 4 * fq) = acc;
      }
      if (tid == 0) { mlg[sidx * 3] = glast; mlg[sidx * 3 + 1] = mloc; }
    }
  }
  __syncthreads();
}

DI void phase_scan(PmK p) {
  LAUNDER(p);
  float* ssds = (float*)(p->ws + OFF_SSDS); const float* ssdd = (const float*)(p->ws + OFF_SSDD);
  float* mls = (float*)(p->ws + OFF_MLS); float* mlg = (float*)(p->ws + OFF_MLG);
  const int gt = blockIdx.x * 512 + otid(), gn = gridDim.x * 512;
  for (int e0 = gt; e0 < 64 * 4096; e0 += 2 * gn) {
    const int e1 = e0 + gn < 64 * 4096 ? e0 + gn : e0;
    const int ch0 = e0 >> 12, el0 = e0 & 4095, ch1 = e1 >> 12, el1 = e1 & 4095;
    float run0 = 0.f, run1 = 0.f;
#pragma unroll 1
    for (int c0 = 0; c0 < NCH; c0 += 13) {
      float t0[13], d0[13], t1[13], d1[13];
#pragma unroll
      for (int j = 0; j < 13; ++j) { t0[j] = ssds[(size_t)(ch0 * NCH + c0 + j) * 4096 + el0]; d0[j] = ssdd[ch0 * NCH + c0 + j];
                                     t1[j] = ssds[(size_t)(ch1 * NCH + c0 + j) * 4096 + el1]; d1[j] = ssdd[ch1 * NCH + c0 + j]; }
#pragma unroll
      for (int j = 0; j < 13; ++j) {
        ssds[(size_t)(ch0 * NCH + c0 + j) * 4096 + el0] = run0; run0 = run0 * d0[j] + t0[j];
        if (e1 != e0) { ssds[(size_t)(ch1 * NCH + c0 + j) * 4096 + el1] = run1; run1 = run1 * d1[j] + t1[j]; }
      }
    }
  }
  for (int e = gt; e < 32 * 9216; e += gn) {
    const int chain = e / 9216, el = e - chain * 9216; float run = 0.f, m = NEGF;
#pragma unroll 1
    for (int c0 = 0; c0 < NCH; c0 += 13) {
      float t[13], gl[13], ml[13];
#pragma unroll
      for (int j = 0; j < 13; ++j) { const int ci = chain * NCH + c0 + j; t[j] = mls[(size_t)ci * 9216 + el]; gl[j] = mlg[ci * 3]; ml[j] = mlg[ci * 3 + 1]; }
#pragma unroll
      for (int j = 0; j < 13; ++j) {
        const int ci = chain * NCH + c0 + j;
        mls[(size_t)ci * 9216 + el] = run;
        if (el == 0) mlg[ci * 3 + 2] = m;
        const float mn = fmaxf(gl[j] + m, ml[j]);
        run = fexp(gl[j] + m - mn) * run + fexp(ml[j] - mn) * t[j]; m = mn;
      }
    }
  }
}

DI void phase_out(PmK p, int l, char* lds) {
  LAUNDER(p);
  const int tid = otid(), wid = tid >> 6, lane = tid & 63, fr = lane & 15, fq = lane >> 4;
  const bf16_t* xc = (const bf16_t*)(p->ws + OFF_XBCC); const float* gates = (const float*)(p->ws + OFF_GATES);
  const bf16_t* mqk = (const bf16_t*)(p->ws + OFF_MQKVO);
  const float* ssds = (const float*)(p->ws + OFF_SSDS); const float* mls = (const float*)(p->ws + OFF_MLS); const float* mlg = (const float*)(p->ws + OFF_MLG);
  bf16_t* mixed = (bf16_t*)(p->ws + OFF_MIXED);
  bf16_t* A0 = (bf16_t*)lds; bf16_t* A1 = A0 + 128 * 72; bf16_t* Vt = A1 + 128 * 72; bf16_t* Ms = Vt + 144 * 136; bf16_t* St = Ms + 128 * 136;
  float* s_a = (float*)(St + 144 * 72); float* s_b = s_a + 128; float* s_cum = s_b + 128; float* s_pm = s_cum + 128;
  constexpr int NS = NB * NCH * 8, NMI = NB * NCH * 4;
  const f32x4 zero4 = {0.f, 0.f, 0.f, 0.f};
  int* const qcnt = (int*)(p->ws + OFF_SCAL) + 18; int* const s_q = (int*)(lds + 136 * 1024);
  for (;;) {
    __syncthreads();
    if (tid == 0) *s_q = atomicAdd(qcnt, 1);
    __syncthreads();
    const int it = *s_q;
    if (it >= NS) break;
    {
      const int hh = it & 7, bc = it >> 3, c = bc % NCH, b = bc / NCH, g = hh >> 2;
      const int r0 = b * TP + c * 128;
#pragma unroll
      for (int i = 0; i < 2; ++i) {
        const int id = tid + 512 * i, lrow = id >> 3, c8 = id & 7;
        *(uint4*)(A0 + lrow * 72 + c8 * 8) = *(const uint4*)(xc + (size_t)(r0 + lrow) * 768 + 640 + g * 64 + c8 * 8);
        *(uint4*)(A1 + lrow * 72 + c8 * 8) = *(const uint4*)(xc + (size_t)(r0 + lrow) * 768 + 512 + g * 64 + c8 * 8);
      }
      __syncthreads();
      f32x4 yacc[4] = {zero4, zero4, zero4, zero4};
      const int lrow_me = 16 * wid + fr;
      for (int dir = 0; dir < 2; ++dir) {
        __syncthreads();
        const float Ah = -expf(p->a_log[l * 16 + dir * 8 + hh]);
        if (tid < 128) { const float dtv = gates[(size_t)(r0 + tid) * 32 + dir * 8 + hh]; s_b[tid] = dtv; s_a[tid] = dtv * Ah; }
        __syncthreads();
        if (wid == 0) scan128_sum(s_a, s_cum, dir, lane);
        __syncthreads();
#pragma unroll
        for (int i = 0; i < 2; ++i) {
          const int id = tid + 512 * i, lrow = id >> 3, c8 = id & 7;
          float xv[8]; ld_bf8(xc + (size_t)(r0 + lrow) * 768 + hh * 64 + c8 * 8, xv);
          const float sc = s_b[lrow];
#pragma unroll
          for (int e = 0; e < 8; ++e) Vt[(c8 * 8 + e) * 136 + lrow] = f2bf(xv[e] * sc);
        }
        const int cp = dir ? NCH - 1 - c : c;
        const size_t sidx = (size_t)((b * 8 + hh) * 2 + dir) * NCH + cp;
#pragma unroll
        for (int i = 0; i < 2; ++i) {
          const int id = tid + 512 * i;
          const f32x4 v = *(const f32x4*)(ssds + sidx * 4096 + id * 4);
          st_bf4(St + (id >> 4) * 72 + (id & 15) * 4, v);
        }
        const float cl = s_cum[lrow_me];
        int lrow_v = lrow_me; asm volatile("" : "+v"(lrow_v));
#pragma unroll 1
        for (int st = 0; st < 8; ++st) {
          f32x4 mv;
          const f32x4 gt_ = mma_lds(A1 + st * 16 * 72, 72, A0 + wid * 16 * 72, 72, 64, zero4, fr, fq);
#pragma unroll
          for (int j = 0; j < 4; ++j) {
            const int s = 16 * st + 4 * fq + j;
            const bool ok = dir ? (s >= lrow_v) : (s <= lrow_v);
            mv[j] = ok ? gt_[j] * fexp(fminf(cl - s_cum[s], 0.f)) : 0.f;
          }
          st_bf4(Ms + lrow_me * 136 + 16 * st + 4 * fq, mv);
        }
        __syncthreads();
        const float el = fexp(cl);
#pragma unroll
        for (int pt = 0; pt < 4; ++pt) {
          const f32x4 a1 = mma_lds(Vt + pt * 16 * 136, 136, Ms + wid * 16 * 136, 136, 128, zero4, fr, fq);
          const f32x4 a2 = mma_lds(St + pt * 16 * 72, 72, A0 + wid * 16 * 72, 72, 64, zero4, fr, fq);
          yacc[pt] += a1 + el * a2;
        }
      }
      const int pp = c * 128 + lrow_me;
      if (pp >= PAD0) {
        const float dsk = p->ssd_d[l * 8 + hh];
        const size_t r = (size_t)r0 + lrow_me;
#pragma unroll
        for (int pt = 0; pt < 4; ++pt) {
          const f32x4 xs = ld_bf4(xc + r * 768 + hh * 64 + pt * 16 + 4 * fq);
          st_bf4(mixed + r * 2048 + 512 + hh * 64 + pt * 16 + 4 * fq, yacc[pt] + dsk * xs);
        }
      }
    }
  }
  for (;;) {
    __syncthreads();
    if (tid == 0) *s_q = atomicAdd(qcnt + 1, 1);
    __syncthreads();
    const int i2 = *s_q;
    if (i2 >= NMI) break;
    {
      const int hm = i2 & 3, bc = i2 >> 2, c = bc % NCH, b = bc / NCH;
      const int r0 = b * TP + c * 128;
#pragma unroll
      for (int i = 0; i < 2; ++i) {
        const int id = tid + 512 * i, lrow = id >> 3, c8 = id & 7;
        float qv[8]; ld_bf8(mqk + (size_t)(r0 + lrow) * 1536 + hm * 64 + c8 * 8, qv);
#pragma unroll
        for (int e = 0; e < 8; ++e) qv[e] *= 0.125f;
        st_bf8(A0 + lrow * 72 + c8 * 8, qv);
        *(uint4*)(A1 + lrow * 72 + c8 * 8) = *(const uint4*)(mqk + (size_t)(r0 + lrow) * 1536 + 256 + hm * 64 + c8 * 8);
      }
#pragma unroll
      for (int i = 0; i < 4; ++i) {
        const int id = tid + 512 * i, lrow = id >> 4, c8 = id & 15;
        const uint4 vw = *(const uint4*)(mqk + (size_t)(r0 + lrow) * 1536 + 512 + hm * 128 + c8 * 8);
        const bf16x8 vv = __builtin_bit_cast(bf16x8, vw);
#pragma unroll
        for (int e = 0; e < 8; ++e) Vt[(c8 * 8 + e) * 136 + lrow] = (bf16_t)vv[e];
      }
      for (int id = tid; id < 16 * 128; id += 512) { const int vr = id >> 7, lrow = id & 127; Vt[(128 + vr) * 136 + lrow] = vr == 0 ? (bf16_t)0x3f80 : (bf16_t)0; }
      __syncthreads();
      f32x4 hacc[8];
#pragma unroll
      for (int vt = 0; vt < 8; ++vt) hacc[vt] = zero4;
      const int lrow_me = 16 * wid + fr;
      for (int dir = 0; dir < 2; ++dir) {
        __syncthreads();
        if (tid < 128) { s_a[tid] = gates[(size_t)(r0 + tid) * 32 + 24 + dir * 4 + hm]; s_b[tid] = gates[(size_t)(r0 + tid) * 32 + 16 + dir * 4 + hm]; }
        __syncthreads();
        if (wid == 0) scan128_sum(s_a, s_cum, dir, lane);
        __syncthreads();
        if (tid < 128) s_a[tid] = s_b[tid] - s_cum[tid];
        __syncthreads();
        if (wid == 0) scan128_max(s_a, s_pm, dir, lane);
        const int cp = dir ? NCH - 1 - c : c;
        const size_t sidx = (size_t)((b * 4 + hm) * 2 + dir) * NCH + cp;
        for (int id = tid; id < 2304; id += 512) {
          const f32x4 v = *(const f32x4*)(mls + sidx * 9216 + id * 4);
          st_bf4(St + (id >> 4) * 72 + (id & 15) * 4, v);
        }
        const float mst = mlg[sidx * 3 + 2];
        __syncthreads();
        const float cl = s_cum[lrow_me];
        int lrow_v = lrow_me; asm volatile("" : "+v"(lrow_v));
        const float mrow = cl + fmaxf(s_pm[lrow_me], mst);
        const float winter = fexp(fminf(cl + mst - mrow, 0.f));
#pragma unroll 1
        for (int st = 0; st < 8; ++st) {
          f32x4 mv;
          const f32x4 s0_ = mma_lds(A1 + st * 16 * 72, 72, A0 + wid * 16 * 72, 72, 64, zero4, fr, fq);
#pragma unroll
          for (int j = 0; j < 4; ++j) {
            const int s = 16 * st + 4 * fq + j;
            const bool ok = dir ? (s >= lrow_v) : (s <= lrow_v);
            mv[j] = ok ? s0_[j] * fexp(fminf(cl + s_a[s] - mrow, 0.f)) : 0.f;
          }
          st_bf4(Ms + lrow_me * 136 + 16 * st + 4 * fq, mv);
        }
        __syncthreads();
        float dd;
        {
          const f32x4 a1 = mma_lds(Vt + 8 * 16 * 136, 136, Ms + wid * 16 * 136, 136, 128, zero4, fr, fq);
          const f32x4 a2 = mma_lds(St + 8 * 16 * 72, 72, A0 + wid * 16 * 72, 72, 64, zero4, fr, fq);
          const float den = __shfl(a1[0] + winter * a2[0], fr);
          dd = 1.f / fmaxf(fabsf(den), fexp(-mrow));
        }
#pragma unroll
        for (int vt = 0; vt < 8; ++vt) {
          const f32x4 a1 = mma_lds(Vt + vt * 16 * 136, 136, Ms + wid * 16 * 136, 136, 128, zero4, fr, fq);
          const f32x4 a2 = mma_lds(St + vt * 16 * 72, 72, A0 + wid * 16 * 72, 72, 64, zero4, fr, fq);
          hacc[vt] += (a1 + winter * a2) * dd;
        }
      }
      const int pp = c * 128 + lrow_me;
      if (pp >= PAD0) {
        const size_t r = (size_t)r0 + lrow_me;
#pragma unroll
        for (int vt = 0; vt < 8; ++vt) st_bf4(mixed + r * 2048 + 1536 + hm * 128 + vt * 16 + 4 * fq, hacc[vt]);
      }
    }
  }
  __syncthreads();
}


#ifndef DBGCHK
#define DBGCHK 0
#endif
#if DBGCHK
DI float blk_max(float v, float* red, int tid) {
  v = wmax(v); __syncthreads(); if ((tid & 63) == 0) red[tid >> 6] = v; __syncthreads();
  float r = red[0]; for (int i = 1; i < 8; ++i) r = fmaxf(r, red[i]); return r;
}
DI float blk_sum(float v, float* red, int tid) {
  v = wsum(v); __syncthreads(); if ((tid & 63) == 0) red[tid >> 6] = v; __syncthreads();
  float r = 0.f; for (int i = 0; i < 8; ++i) r += red[i]; return r;
}
DI void dbg_check_attn(PmK p, char* lds) {
  LAUNDER(p);
  const int tid = otid();
  float* w = (float*)lds; float* red = w + 8320;
  const int b = 1, j = 2, h = 1, pq = 5000;
  const bf16_t* base = (const bf16_t*)(p->ws + OFF_DQKV) + (size_t)b * TP * 1536;
  const bf16_t* mixed = (const bf16_t*)(p->ws + OFF_MIXED);
  float mx = NEGF;
  for (int t = PAD0 + tid; t < TP; t += 512) {
    float s = 0.f;
    for (int c = 0; c < 64; ++c) s += bf2f(base[(size_t)pq * 1536 + j * 64 + c]) * bf2f(base[(size_t)t * 1536 + 512 + j * 64 + c]);
    w[t] = s; mx = fmaxf(mx, s);
  }
  const float M = blk_max(mx, red, tid);
  float ls = 0.f;
  for (int t = PAD0 + tid; t < TP; t += 512) { const float e = __builtin_amdgcn_exp2f(w[t] - M); w[t] = e; ls += e; }
  const float L = blk_sum(ls, red, tid);
  __syncthreads();
  float err = 0.f, mag = 0.f;
  if (tid < 128) {
    float o = 0.f;
    for (int t = PAD0; t < TP; ++t) o += w[t] * bf2f(base[(size_t)t * 1536 + 1024 + h * 128 + tid]);
    o /= L;
    const float kv = bf2f(mixed[((size_t)b * TP + pq) * 2048 + 1024 + h * 128 + tid]);
    err = fabsf(o - kv); mag = fabsf(o);
  }
  const float E = blk_max(err, red, tid), G = blk_max(mag, red, tid);
  if (tid == 0) ((float*)(p->ws + OFF_SCAL))[8] = 1000.f + 1000.f * fminf(E / G, 50.f);
}

DI void dbg_check_p2x(PmK p, int l, char* lds) {
  LAUNDER(p);
  const int tid = otid();
  float* raw = (float*)lds; float* red = raw + 256;
  const int b = 1, pq = 5000, r = b * TP + pq;
  const bf16_t* hn = (const bf16_t*)(p->ws + OFF_HN); const bf16_t* win = (const bf16_t*)(p->ws + OFF_WIN);
  const bf16_t* dqkv = (const bf16_t*)(p->ws + OFF_DQKV);
  float err = 0.f, mag = 0.f;
  for (int hsel = 0; hsel < 2; ++hsel) {
    const int hd = hsel ? 19 : 17;
    __syncthreads();
    if (tid < 64) { float a = 0.f; for (int k = 0; k < 1024; ++k) a += bf2f(hn[(size_t)r * 1024 + k]) * bf2f(win[(size_t)(672 + hd * 64 + tid) * 1024 + k]); raw[tid] = a; }
    __syncthreads();
    if (tid < 64) {
      float ss = 0.f; for (int c = 0; c < 64; ++c) ss += raw[c] * raw[c];
      const float rinv = rsqrtf(ss / 64.f + 1e-6f) * (hd < 8 ? 0.125f * LOG2E : 1.f);
      const float* g = (hd < 8 ? p->dq_g : p->dk_g) + l * 64; if (hd >= 16) g = p->dq_g;
      auto nv = [&](int c) { return raw[c] * rinv * g[c]; };
      float o = nv(tid);
      if (tid < 16) { const int i = tid & 7; float cs, sn; sincos_rev((float)(pq - PAD0) * p->inv_d[i], cs, sn);
        o = tid < 8 ? nv(tid) * cs - nv(tid + 8) * sn : nv(tid) * cs + nv(tid - 8) * sn; }
      const float kv = bf2f(dqkv[(size_t)r * 1536 + hd * 64 + tid]);
      if (hd >= 16) o = raw[tid];
      err = fmaxf(err, fabsf(o - kv)); mag = fmaxf(mag, fabsf(o));
    }
  }
  const float E = blk_max(err, red, tid), G = blk_max(mag, red, tid);
  if (tid == 0) ((float*)(p->ws + OFF_SCAL))[8] = 1000.f + 1000.f * fminf(E / G, 50.f);
}
#endif
#define EPI_WRAP(name, f) auto name = [=](const f32x4 (&acc)[2][2][4][2], int pm, int pn, int wr, int wc, int fr, int fq) { epi_each(acc, pm, pn, wr, wc, fr, fq, f); }
__global__ void __launch_bounds__(512) mega(Pm p_unused) {
  PmK p = (PmK)__builtin_amdgcn_kernarg_segment_ptr();
  char* const lds = g_lds;
  cg::grid_group grid = cg::this_grid();
  { const int t0 = threadIdx.x; const int key = __builtin_amdgcn_s_getreg(10244) & 63;
    if ((t0 & 63) == 0) ((volatile int*)(g_lds + WID_TAB_OFF))[key] = t0 >> 6;
    if (t0 < 4) ((volatile int*)(g_lds + WID_TAB_OFF + 512))[t0] = 0;
    __syncthreads(); }
  (void)xcd_barrier_post((unsigned*)(p->ws + OFF_BAR), (volatile LAS unsigned*)(g_lds + WID_TAB_OFF + 512), threadIdx.x == 0);
  const int lo = p->ph0, hi = p->ph1;
#define IN(k) ((ONLY < 0 || ONLY == (k)) && lo <= l * NPH + (k) && l * NPH + (k) < hi)
#define SEAM(k) do { if (l * NPH + (k) + 1 < hi) { if (l == 0 && (k) == 0) grid.sync(); else seam_barrier(p); } } while (0)
#pragma unroll
  for (int l = 0; l < 2; ++l) {
    if (IN(0)) { LAUNDER(p); char* const ws = p->ws; (void)ws; phase_prep(p, l, lds); if (DUP & 8) phase_prep(p, l, lds); SEAM(0); }
    if (IN(1)) { LAUNDER(p); char* const ws = p->ws; (void)ws;
      bf16_t* pa = (bf16_t*)(ws + OFF_PA); bf16_t* dqkv = (bf16_t*)(ws + OFF_DQKV);
      auto f = [=](int row, int col, f32x4 v0, f32x4 v1) {
        if (col < 672) st_bf8v(pa + (size_t)row * 672 + col, v0, v1);
        else if (col < 2208) st_bf8v(dqkv + (size_t)row * 1536 + (col - 672), v0, v1);
      };
      auto epi = [=](const f32x4 (&acc)[2][2][4][2], int pm, int pn, int wr, int wc, int fr, int fq) { epi_each8(acc, pm, pn, wr, wc, fr, fq, f); };
      gemm_fast_p(lds, (const bf16_t*)(ws + OFF_HN), 1024, (const bf16_t*)(ws + OFF_WIN), 1024, R / 256, XW / 256, 1024, epi);
      SEAM(1);
    }
    if (IN(2)) { LAUNDER(p); char* const ws = p->ws; (void)ws;
      bf16_t* mq = (bf16_t*)(ws + OFF_MQ); bf16_t* knr = (bf16_t*)(ws + OFF_KNR); bf16_t* mv = (bf16_t*)(ws + OFF_MVR);
      auto fq_ = [=](int row, int col, f32x4 v0, f32x4 v1) { st_bf8v(mq + (size_t)row * 768 + col, v0, v1); };
      auto epiq = [=](const f32x4 (&acc)[2][2][4][2], int pm, int pn, int wr, int wc, int fr, int fq) { epi_each8(acc, pm, pn, wr, wc, fr, fq, fq_); };
      gemm_fast_p(lds, (const bf16_t*)(ws + OFF_PA), 672, (const bf16_t*)(ws + OFF_WUQ), 384, R / 256, 3, 384, epiq);
      auto fkv = [=](int row, int col, f32x4 v0, f32x4 v1) {
        const int hh = col >> 7, c = col & 127;
        if (c < 64) st_bf8v(knr + (size_t)row * 512 + hh * 64 + c, v0, v1); else st_bf8v(mv + (size_t)row * 512 + hh * 64 + (c - 64), v0, v1);
      };
      auto epikv = [=](const f32x4 (&acc)[2][2][4][2], int pm, int pn, int wr, int wc, int fr, int fq) { epi_each8(acc, pm, pn, wr, wc, fr, fq, fkv); };
      gemm_fast_p(lds, (const bf16_t*)(ws + OFF_PA) + 384, 672, (const bf16_t*)(ws + OFF_WUKV), 256, R / 256, 4, 256, epikv);
      SEAM(2);
    }
    if (IN(3)) { LAUNDER(p); char* const ws = p->ws; (void)ws; phase_p3(p, l, lds); phase_p2x(p, l); vtrans_items(p, lds); SEAM(3); }
    if (IN(4)) { LAUNDER(p); char* const ws = p->ws; (void)ws; for (int rep = 0; rep < ((DUP & 2) ? 2 : 1); ++rep) phase_attn(p, lds, rep); SEAM(4); }
    if (IN(5)) { LAUNDER(p); char* const ws = p->ws; (void)ws;
      bf16_t* sz = (bf16_t*)(ws + OFF_SZ); bf16_t* xr = (bf16_t*)(ws + OFF_XBCR); bf16_t* mo = (bf16_t*)(ws + OFF_MQKVO); float* gates = (float*)(ws + OFF_GATES);
      auto f = [=](int row, int col, f32x4 v0, f32x4 v1) {
        if (col < 512) st_bf8v(sz + (size_t)row * 512 + col, v0, v1);
        else if (col < 1280) st_bf8v(xr + (size_t)row * 768 + (col - 512), v0, v1);
        else if (col < 2816) st_bf8v(mo + (size_t)row * 1536 + (col - 1280), v0, v1);
        else if (col < 2848) { float* gp = gates + (size_t)row * 32 + (col - 2816); *(f32x4*)gp = v0; *(f32x4*)(gp + 4) = v1; }
      };
      auto epi = [=](const f32x4 (&acc)[2][2][4][2], int pm, int pn, int wr, int wc, int fr, int fq) { epi_each8(acc, pm, pn, wr, wc, fr, fq, f); };
      gemm_fast_p(lds, (const bf16_t*)(ws + OFF_HN), 1024, (const bf16_t*)(ws + OFF_WIN) + (size_t)XW * 1024, 1024, R / 256, YW / 256, 1024, epi);
      SEAM(5);
    }
    if (IN(6)) { LAUNDER(p); char* const ws = p->ws; (void)ws; phase_p2y(p, l); SEAM(6); }
    if (IN(7)) { LAUNDER(p); char* const ws = p->ws; (void)ws; phase_states(p, l, lds); if (DUP & 4) phase_states(p, l, lds); SEAM(7); }
    if (IN(8)) { LAUNDER(p); char* const ws = p->ws; (void)ws; phase_scan(p); SEAM(8); }
    if (IN(9)) { LAUNDER(p); char* const ws = p->ws; (void)ws; phase_out(p, l, lds); if (DUP & 4) phase_out(p, l, lds); SEAM(9); }
    if (IN(10)) { LAUNDER(p); char* const ws = p->ws; (void)ws; phase_post(p, l); SEAM(10); }
    if (IN(11)) { LAUNDER(p); char* const ws = p->ws; (void)ws;
      float* const outp = p->out; float* const metah = (float*)(ws + OFF_METAH);
      const float* const xs = p->x; const float* const mt = p->meta; const bool first = (l == 0);
      auto f = [=](int row, int col, f32x4 v) {
        float* hr = hrow2(outp, metah, row);
        if (hr) {
          const float* sr = hr;
          if (first) { const int b = row / TP, pp = row - b * TP; sr = pp < 128 ? mt + (size_t)(pp - PAD0) * 1024 : xs + ((size_t)b * 8192 + pp - 128) * 1024; }
          *(f32x4*)(hr + col) = *(const f32x4*)(sr + col) + v;
        }
      };
      EPI_WRAP(epi, f);
      gemm_fast(lds, (const bf16_t*)(ws + OFF_MIXED), 2048, (const bf16_t*)(ws + OFF_WOUT), 2048, R / 256, 4, 2048, epi);
      SEAM(11);
    }
    if (IN(12)) { LAUNDER(p); char* const ws = p->ws; (void)ws; norm_rows(p, false); SEAM(12); }
    if (IN(13)) { LAUNDER(p); char* const ws = p->ws; (void)ws;
      bf16_t* act = (bf16_t*)(ws + OFF_ACT);
      auto epi = [=](const f32x4 (&acc)[2][2][4][2], int pm, int pn, int wr, int wc, int fr, int fq) {
#pragma unroll
        for (int ai = 0; ai < 2; ++ai)
#pragma unroll
          for (int m = 0; m < 4; ++m) {
            const int row = pm * 256 + 128 * ai + 64 * wr + 16 * m + fr;
            f32x4 a[2];
#pragma unroll
            for (int n = 0; n < 2; ++n) {
              const f32x4 g = acc[ai][0][m][n], u = acc[ai][1][m][n];
              a[n][0] = siluf(g[0]) * u[0]; a[n][1] = siluf(g[1]) * u[1]; a[n][2] = siluf(g[2]) * u[2]; a[n][3] = siluf(g[3]) * u[3];
            }
            st_bf8v(act + (size_t)row * 2816 + pn * 128 + 32 * wc + 8 * fq, a[0], a[1]);
          }
      };
      gemm_fast_p(lds, (const bf16_t*)(ws + OFF_HN), 1024, (const bf16_t*)(ws + OFF_WFI), 1024, R / 256, 22, 1024, epi);
      if (DUP & 1) gemm_fast_p(lds, (const bf16_t*)(ws + OFF_HN), 1024, (const bf16_t*)(ws + OFF_WFI), 1024, R / 256, 22, 1024, epi);
      SEAM(13);
    }
    if (IN(14)) { LAUNDER(p); char* const ws = p->ws; (void)ws;
      float* const outp = p->out; float* const metah = (float*)(ws + OFF_METAH);
      auto f = [=](int row, int col, f32x4 v) { float* hr = hrow2(outp, metah, row); if (hr) { f32x4* d = (f32x4*)(hr + col); *d = *d + v; } };
      EPI_WRAP(epi, f);
      gemm_fast(lds, (const bf16_t*)(ws + OFF_ACT), 2816, (const bf16_t*)(ws + OFF_WFO), 2816, R / 256, 4, 2816, epi);
      SEAM(14);
    }
  }
#undef IN
#undef SEAM
#if DBGCHK
  grid.sync();
  if (blockIdx.x == 0) dbg_check_p2x(p, 0, lds);
  grid.sync();
  { float* o = p->out; const float code = ((const float*)(p->ws + OFF_SCAL))[8];
    for (size_t i = (size_t)blockIdx.x * 512 + threadIdx.x; i < (size_t)4 * 8192 * 1024; i += (size_t)gridDim.x * 512) o[i] = i == 0 ? code : 0.f; }
#endif
}

__global__ void __launch_bounds__(512) dbg_hash(const unsigned* ws, size_t nwords, float* out) {
  const size_t gt = (size_t)blockIdx.x * 512 + threadIdx.x, gn = (size_t)gridDim.x * 512;
  unsigned h = 0;
  for (size_t i = gt; i < nwords; i += gn) h = h * 31u + ws[i];
  out[gt] = (float)(h & 0xFFFFFu);
}
constexpr size_t LDS_BYTES = 140 * 1024;
extern "C" void kernel_launch(void* const* d_in, const int* in_sizes, int n_in, void* d_out, int out_size, void* d_ws, size_t ws_size, hipStream_t stream) {
  static int grid_blocks = 0;
  if (!grid_blocks) {
    if (ws_size < WS_NEED) { fprintf(stderr, "kernel_launch: workspace too small: %zu < %zu\n", ws_size, WS_NEED); return; }
    if (hipFuncSetAttribute((const void*)mega, hipFuncAttributeMaxDynamicSharedMemorySize, (int)LDS_BYTES) != hipSuccess) { fprintf(stderr, "kernel_launch: LDS attribute failed\n"); return; }
    int dev = 0, cus = 0, per_cu = 0;
    hipGetDevice(&dev);
    hipDeviceGetAttribute(&cus, hipDeviceAttributeMultiprocessorCount, dev);
    hipOccupancyMaxActiveBlocksPerMultiprocessor(&per_cu, mega, 512, LDS_BYTES);
    if (per_cu < 1) { fprintf(stderr, "kernel_launch: occupancy 0\n"); return; }
    grid_blocks = cus * 1;
  }
  Pm p;
  memset(&p, 0, sizeof(p));
  const float** fp = (const float**)&p;
  for (int i = 0; i < 28; ++i) fp[i] = (const float*)d_in[i];
  p.out = (float*)d_out; p.ws = (char*)d_ws;
  for (int i = 0; i < 16; ++i) p.inv_m[i] = 1.0f / powf(500000.0f, (float)(2 * i) / 32.0f);
  for (int i = 0; i < 8; ++i) p.inv_d[i] = 1.0f / powf(500000.0f, (float)(2 * i) / 16.0f);
  for (int l = 0; l < 2; ++l) p.linit[l] = (float)(0.8 - 0.6 * exp(-0.3 * l));
  hipMemsetAsync((char*)d_ws + OFF_BAR, 0, 16384, stream);
#if MULTI
  for (int ph = 0; ph < DBG_NPH; ++ph) {
    p.ph0 = ph; p.ph1 = ph + 1;
    hipLaunchKernelGGL(mega, dim3(grid_blocks), dim3(512), LDS_BYTES, stream, p);
  }
#else
  p.ph0 = 0; p.ph1 = DBGCHK ? 5 : 2 * NPH;
  void* args[] = {&p};
  hipError_t e = hipLaunchCooperativeKernel((void*)mega, dim3(grid_blocks), dim3(512), args, LDS_BYTES, stream);
  if (e != hipSuccess) fprintf(stderr, "cooperative launch failed: %s (grid %d)\n", hipGetErrorString(e), grid_blocks);
#endif
}
```
